# Optimizing an MI355X kernel written in HIP

```python
import jax, jax.numpy as jnp
from jax import lax
import numpy as np

D_MODEL = 1024
BATCH = 32
SEQ = 2048
DEPTH = 2

N_MIXERS = 2
EXPAND = 2
D_INNER = EXPAND * D_MODEL
HEAD_DIM = 64
N_HEADS = D_INNER // HEAD_DIM
Q_BLOCK = 128
NORM_EPS = 1e-6
N_FOX = (DEPTH + N_MIXERS - 1) // N_MIXERS
N_SB = DEPTH // N_MIXERS
FOX_IN = 4 * D_INNER + N_HEADS
SB_IN = 4 * D_INNER

kernel_name = "hybrid_fox_stickbreaking_adaln"


def rmsnorm(x, g):
    xf = x.astype(jnp.float32)
    y = xf * lax.rsqrt(jnp.mean(xf * xf, axis=-1, keepdims=True) + NORM_EPS)
    return (y * g.astype(jnp.float32)).astype(x.dtype)


def adaln(c, w_ada, b_ada):
    mod = jax.nn.silu(c) @ w_ada + b_ada
    shift, scale, gate = jnp.split(mod, 3, axis=-1)
    return shift[:, None, :], scale[:, None, :], gate[:, None, :]


def split_heads(t):
    b, s, _ = t.shape
    return t.reshape(b, s, N_HEADS, HEAD_DIM).transpose(0, 2, 1, 3)


def merge_heads(t):
    b, h, s, d = t.shape
    return t.transpose(0, 2, 1, 3).reshape(b, s, h * d)


def forgetting_attention(q, k, v, log_f):
    seq = q.shape[2]
    cum = jnp.cumsum(log_f, axis=-1)
    sm_scale = HEAD_DIM ** -0.5
    outs = []
    for blk in range(seq // Q_BLOCK):
        q0, q1 = blk * Q_BLOCK, (blk + 1) * Q_BLOCK
        qb, kp, vp = q[:, :, q0:q1], k[:, :, :q1], v[:, :, :q1]
        logits = jnp.einsum("bhtd,bhsd->bhts", qb, kp,
                            preferred_element_type=jnp.float32) * sm_scale
        logits = logits + cum[:, :, q0:q1, None] - cum[:, :, None, :q1]
        t_idx = jnp.arange(q0, q1)[:, None]
        s_idx = jnp.arange(q1)[None, :]
        logits = jnp.where(s_idx <= t_idx, logits, -jnp.inf)
        p = jax.nn.softmax(logits, axis=-1)
        outs.append(jnp.einsum("bhts,bhsd->bhtd", p.astype(vp.dtype), vp))
    return jnp.concatenate(outs, axis=2)


def stick_breaking_attention(q, k, v):
    seq = q.shape[2]
    sm_scale = HEAD_DIM ** -0.5
    outs = []
    for blk in range(seq // Q_BLOCK):
        q0, q1 = blk * Q_BLOCK, (blk + 1) * Q_BLOCK
        qb, kp, vp = q[:, :, q0:q1], k[:, :, :q1], v[:, :, :q1]
        z = jnp.einsum("bhtd,bhsd->bhts", qb, kp,
                       preferred_element_type=jnp.float32) * sm_scale
        t_idx = jnp.arange(q0, q1)[:, None]
        s_idx = jnp.arange(q1)[None, :]
        strict = s_idx < t_idx
        log_beta = jax.nn.log_sigmoid(z)
        log_keep = jnp.where(strict, jax.nn.log_sigmoid(-z), 0.0)
        after = lax.cumsum(log_keep, axis=3, reverse=True) - log_keep
        a = jnp.where(strict, jnp.exp(log_beta + after), 0.0)
        outs.append(jnp.einsum("bhts,bhsd->bhtd", a.astype(vp.dtype), vp))
    return jnp.concatenate(outs, axis=2)


def fox_layer(x, c, norm_g, w_ada, b_ada, w_in, b_f, w_out):
    shift, scale, gate = adaln(c, w_ada, b_ada)
    h = rmsnorm(x, norm_g) * (1.0 + scale) + shift
    proj = h @ w_in
    q, k, v, zg = (proj[..., i * D_INNER:(i + 1) * D_INNER] for i in range(4))
    f_logit = proj[..., 4 * D_INNER:] + b_f
    log_f = jax.nn.log_sigmoid(f_logit.astype(jnp.float32)).transpose(0, 2, 1)
    o = forgetting_attention(split_heads(q), split_heads(k), split_heads(v), log_f)
    y = (merge_heads(o) * jax.nn.silu(zg)) @ w_out
    return x + gate * y


def sb_layer(x, c, norm_g, w_ada, b_ada, w_in, w_out):
    shift, scale, gate = adaln(c, w_ada, b_ada)
    h = rmsnorm(x, norm_g) * (1.0 + scale) + shift
    proj = h @ w_in
    q, k, v, zg = (proj[..., i * D_INNER:(i + 1) * D_INNER] for i in range(4))
    o = stick_breaking_attention(split_heads(q), split_heads(k), split_heads(v))
    y = (merge_heads(o) * jax.nn.silu(zg)) @ w_out
    return x + gate * y


def setup_inputs(seed: int = 0) -> dict:
    key = jax.random.key(seed)
    ks = jax.random.split(key, 16)
    f32 = jnp.float32
    din = D_MODEL ** -0.5
    dinner = D_INNER ** -0.5
    x = jax.random.normal(ks[0], (BATCH, SEQ, D_MODEL), f32)
    c = jax.random.normal(ks[1], (BATCH, D_MODEL), f32)
    fox_norm_g = 1.0 + 0.02 * jax.random.normal(ks[2], (N_FOX, D_MODEL), f32)
    fox_w_ada = 0.5 * din * jax.random.normal(ks[3], (N_FOX, D_MODEL, 3 * D_MODEL), f32)
    fox_b_ada = 0.02 * jax.random.normal(ks[4], (N_FOX, 3 * D_MODEL), f32)
    fox_w_in = din * jax.random.normal(ks[5], (N_FOX, D_MODEL, FOX_IN), f32)
    fox_b_f = 1.0 + 0.5 * jax.random.normal(ks[6], (N_FOX, N_HEADS), f32)
    fox_w_out = dinner * jax.random.normal(ks[7], (N_FOX, D_INNER, D_MODEL), f32)
    sb_norm_g = 1.0 + 0.02 * jax.random.normal(ks[8], (N_SB, D_MODEL), f32)
    sb_w_ada = 0.5 * din * jax.random.normal(ks[9], (N_SB, D_MODEL, 3 * D_MODEL), f32)
    sb_b_ada = 0.02 * jax.random.normal(ks[10], (N_SB, 3 * D_MODEL), f32)
    sb_w_in = din * jax.random.normal(ks[11], (N_SB, D_MODEL, SB_IN), f32)
    sb_w_out = dinner * jax.random.normal(ks[12], (N_SB, D_INNER, D_MODEL), f32)
    final_norm_g = 1.0 + 0.02 * jax.random.normal(ks[13], (D_MODEL,), f32)
    return {"x": x, "c": c,
            "fox_norm_g": fox_norm_g, "fox_w_ada": fox_w_ada, "fox_b_ada": fox_b_ada,
            "fox_w_in": fox_w_in, "fox_b_f": fox_b_f, "fox_w_out": fox_w_out,
            "sb_norm_g": sb_norm_g, "sb_w_ada": sb_w_ada, "sb_b_ada": sb_b_ada,
            "sb_w_in": sb_w_in, "sb_w_out": sb_w_out,
            "final_norm_g": final_norm_g}


def reference(x, c, fox_norm_g, fox_w_ada, fox_b_ada, fox_w_in, fox_b_f, fox_w_out,
              sb_norm_g, sb_w_ada, sb_b_ada, sb_w_in, sb_w_out, final_norm_g):
    for i in range(DEPTH):
        j = i // N_MIXERS
        if i % N_MIXERS == 0:
            x = fox_layer(x, c, fox_norm_g[j], fox_w_ada[j], fox_b_ada[j],
                          fox_w_in[j], fox_b_f[j], fox_w_out[j])
        else:
            x = sb_layer(x, c, sb_norm_g[j], sb_w_ada[j], sb_b_ada[j],
                         sb_w_in[j], sb_w_out[j])
    return rmsnorm(x, final_norm_g)
```

```cpp
#include <hip/hip_runtime.h>
#include <hip/hip_cooperative_groups.h>
#include <hip/hip_bf16.h>
#include <cstdio>
#include <cstdint>
#include <cmath>
#include <type_traits>
namespace cg = cooperative_groups;
namespace pg8 {
#define PG8_LAS __attribute__((address_space(3)))
typedef unsigned short bf16_t;
typedef short bf16x8 __attribute__((ext_vector_type(8)));
typedef float f32x4 __attribute__((ext_vector_type(4)));
typedef unsigned u32x4 __attribute__((ext_vector_type(4)));
constexpr int BM = 256, BK = 64, HALF = 128, HTB = HALF * BK * 2  , STAGE_BYTES = 8 * HTB, NXCD = 8, WGM = 8;

__host__ __device__ __forceinline__ int lds_byte(int r, int c) { const int st = (r >> 4) * 2 + (c >> 5), rr = r & 15, cc = c & 31, ob = rr * 64 + cc * 2; return st * 1024 + (ob ^ (((ob >> 9) & 1) << 5)); }
__host__ __device__ __forceinline__ void stage_rc(int b, int& R, int& C) { const int st = b / 1024, sb = b % 1024, swz = sb ^ (((sb >> 9) & 1) << 5); R = (st >> 1) * 16 + swz / 64; C = (st & 1) * 32 + (swz % 64) / 2; }
__host__ __device__ __forceinline__ int perm32(int rho) { const int n = rho >> 4, i = rho & 15; return 8 * (i >> 2) + 4 * n + (i & 3); }

struct Unit { int pm, pn; };
struct Gemm { const bf16_t* A; const bf16_t* Bt; int M, N, K; };

struct StaticOrder {
    int nM, nN, nwg, G, c;
    __host__ __device__ void init(int M, int N, int G_, int c_) { nM = M / BM; nN = N / BM; nwg = nM * nN; G = G_; c = c_; }
    __host__ __device__ bool next(int i, Unit& u) const {
        const long L = (long)i * G + c; if (L >= nwg) return false;
        int wgid = (int)L; { const int q = nwg / NXCD, r = nwg % NXCD, xcd = wgid % NXCD, off = wgid / NXCD; wgid = (xcd < r ? xcd * (q + 1) : r * (q + 1) + (xcd - r) * q) + off; }
        const int nig = WGM * nN, gid = wgid / nig, fm = gid * WGM, gsz = (nM - fm) < WGM ? (nM - fm) : WGM;
        u.pm = fm + ((wgid % nig) % gsz); u.pn = (wgid % nig) / gsz; return true;
    }
    __device__ __forceinline__ void a_ready(const Unit&) const {}
    __device__ __forceinline__ void done(const Unit&) const {}
};

__device__ __forceinline__ unsigned cvt_pk_bf16(float lo, float hi) { unsigned r; asm volatile("v_cvt_pk_bf16_f32 %0, %1, %2" : "=v"(r) : "v"(lo), "v"(hi)); return r; }
typedef float f32x2 __attribute__((ext_vector_type(2)));
typedef float f32x2 __attribute__((ext_vector_type(2)));
struct EpiProj {
    static constexpr bool PERM = true, AFTER_DRAIN = false;
    bf16_t* O; size_t split_stride; float scale0; float* lf; const float* bf;
    __device__ __forceinline__ void operator()(const f32x4 (&acc)[2][2][4][2], const Unit& u, int wr, int wc, int fr, int fq) const {
        const int t = u.pn >> 3;
        const int row0 = u.pm * BM + wr * 64 + fr;
        if (t < 4) {
            bf16_t* base = O + (size_t)t * split_stride; const float sc = (t == 0) ? scale0 : 1.f;
            const int col0 = (u.pn & 7) * BM + wc * 32 + 8 * fq;
#pragma unroll
            for (int ai = 0; ai < 2; ++ai)
#pragma unroll
                for (int m = 0; m < 4; ++m) { bf16_t* rowp = base + (size_t)(row0 + ai * HALF + m * 16) * 2048 + col0;
#pragma unroll
                    for (int bj = 0; bj < 2; ++bj) { f32x4 v0 = acc[ai][bj][m][0] * sc, v1 = acc[ai][bj][m][1] * sc;
                        u32x4 w; w.x = cvt_pk_bf16(v0[0], v0[1]); w.y = cvt_pk_bf16(v0[2], v0[3]); w.z = cvt_pk_bf16(v1[0], v1[1]); w.w = cvt_pk_bf16(v1[2], v1[3]);
                        *(u32x4*)(rowp + bj * HALF) = w; } }
        } else if (wc == 0) {
            f32x4 bv[2];
#pragma unroll
            for (int n = 0; n < 2; ++n) bv[n] = *(const f32x4*)(bf + 8 * fq + 4 * n);
#pragma unroll
            for (int ai = 0; ai < 2; ++ai)
#pragma unroll
                for (int m = 0; m < 4; ++m) { float* rowp = lf + (size_t)(row0 + ai * HALF + m * 16) * 32 + 8 * fq;
#pragma unroll
                    for (int n = 0; n < 2; ++n) { f32x4 v = acc[ai][0][m][n] + bv[n]; f32x4 o;
#pragma unroll
                        for (int e = 0; e < 4; ++e) { const float xx = v[e]; o[e] = (fminf(xx, 0.f) - log1pf(__expf(-fabsf(xx)))) * 1.4426950408889634f; }
                        *(f32x4*)(rowp + 4 * n) = o; } }
        }
    }
};
struct EpiRes {
    static constexpr bool PERM = false, AFTER_DRAIN = false;
    const float* base; float* out; const float* gate; int row_off;
    __device__ __forceinline__ void operator()(const f32x4 (&acc)[2][2][4][2], const Unit& u, int wr, int wc, int fr, int fq) const {
        const int col0 = u.pn * BM + wc * 32 + 4 * fq; const int b = (row_off + u.pm * BM) >> 11;
        f32x4 gv[2][2];
#pragma unroll
        for (int bj = 0; bj < 2; ++bj)
#pragma unroll
            for (int n = 0; n < 2; ++n) gv[bj][n] = *(const f32x4*)(gate + (size_t)b * 3072 + col0 + bj * HALF + n * 16);
#pragma unroll
        for (int ai = 0; ai < 2; ++ai)
#pragma unroll
            for (int m = 0; m < 4; ++m) { const size_t off = (size_t)(row_off + u.pm * BM + wr * 64 + fr + ai * HALF + m * 16) * 1024 + col0;
#pragma unroll
                for (int bj = 0; bj < 2; ++bj)
#pragma unroll
                    for (int n = 0; n < 2; ++n) { const f32x4 bs = *(const f32x4*)(base + off + bj * HALF + n * 16);
                        *(f32x4*)(out + off + bj * HALF + n * 16) = bs + gv[bj][n] * acc[ai][bj][m][n]; } }
    }
};
template <class Epi, class Sched, bool ALIGN_EPI = false, bool SP2 = false>
__device__ __forceinline__ void gemm_phase(PG8_LAS unsigned char* lds, const Gemm g, const Sched& S, const Epi& E) {
    int tid_ = threadIdx.x; asm volatile("" : "+v"(tid_));
    const int tid = tid_, wid = __builtin_amdgcn_readfirstlane(tid >> 6), lane = tid & 63, wr = wid >> 2, wc = wid & 3, fr = lane & 15, fq = lane >> 4;
    const int K = g.K, nt = K / BK;
    unsigned voffA[2], voffB[2];
#pragma unroll
    for (int i = 0; i < 2; ++i) { int R, C; stage_rc(tid * 16 + i * 8192, R, C); const int Rb = Epi::PERM ? ((R & ~31) + perm32(R & 31)) : R;
        voffA[i] = (unsigned)(R * K + C) * 2u; voffB[i] = (unsigned)(Rb * K + C) * 2u; }
    const size_t kstep = (size_t)(BK * 2);
    const size_t hstep = (size_t)HALF * K * 2;
    const size_t tstep = 2 * hstep;
    const unsigned ldsw = (unsigned)wid * 1024u;
    const int aoff = lds_byte(wr * 64 + fr, fq * 8), boff = lds_byte(wc * 32 + fr, fq * 8);
#define PG8_SA(b, h) (((b) * 2 + (h)) * HTB)
#define PG8_SB(b, h) ((4 + (b) * 2 + (h)) * HTB)
#define PG8_STAGE(bufoff, gbase, voff) do { _Pragma("unroll") for (int _i = 0; _i < 2; ++_i) \
        __builtin_amdgcn_global_load_lds((const unsigned*)((const char*)(gbase) + (voff)[_i]), (PG8_LAS unsigned*)(lds + (bufoff) + ldsw + _i * 8192), 16, 0, 0); } while (0)
#define PG8_LDA(dst, b, h) do { _Pragma("unroll") for (int m = 0; m < 4; ++m) _Pragma("unroll") for (int k = 0; k < 2; ++k) dst[m][k] = *(const PG8_LAS bf16x8*)(lds + PG8_SA(b, h) + aoff + m * 2048 + k * 1024); } while (0)
#define PG8_LDB(dst, b, h) do { _Pragma("unroll") for (int n = 0; n < 2; ++n) _Pragma("unroll") for (int k = 0; k < 2; ++k) dst[n][k] = *(const PG8_LAS bf16x8*)(lds + PG8_SB(b, h) + boff + n * 2048 + k * 1024); } while (0)
#define PG8_MMA(ai, bj, At, Bt) do { __builtin_amdgcn_s_setprio(1); _Pragma("unroll") for (int m = 0; m < 4; ++m) _Pragma("unroll") for (int n = 0; n < 2; ++n) _Pragma("unroll") for (int k = 0; k < 2; ++k) \
        acc[ai][bj][m][n] = __builtin_amdgcn_mfma_f32_16x16x32_bf16(Bt[n][k], At[m][k], acc[ai][bj][m][n], 0, 0, 0); __builtin_amdgcn_s_setprio(0); } while (0)
#define PG8_WAIT_V(n) asm volatile("s_waitcnt vmcnt(" #n ")" ::: "memory")
#define PG8_WAIT_L(n) asm volatile("s_waitcnt lgkmcnt(" #n ")" ::: "memory")
#define PG8_BAR __builtin_amdgcn_s_barrier()
#define PG8_SCHED __builtin_amdgcn_sched_barrier(0)
    Unit cur, nxt; int ui = 0;
    if (!S.next(0, cur)) return;
    f32x4 acc[2][2][4][2];
#pragma unroll
    for (int a = 0; a < 2; ++a)
#pragma unroll
        for (int b = 0; b < 2; ++b)
#pragma unroll
            for (int m = 0; m < 4; ++m)
#pragma unroll
                for (int n = 0; n < 2; ++n) acc[a][b][m][n] = (f32x4){0.f, 0.f, 0.f, 0.f};
    bf16x8 At[4][2], B0[2][2], B1[2][2];
    const char* cA = (const char*)g.A + (size_t)cur.pm * tstep; const char* cB = (const char*)g.Bt + (size_t)cur.pn * tstep;
    S.a_ready(cur);
    if constexpr (SP2) {
        PG8_STAGE(PG8_SB(0, 0), cB, voffB); PG8_STAGE(PG8_SB(0, 1), cB + hstep, voffB); PG8_STAGE(PG8_SA(0, 0), cA, voffA); PG8_STAGE(PG8_SA(0, 1), cA + hstep, voffA);
        if (wr == 1) PG8_BAR;
        PG8_WAIT_V(2); PG8_BAR;
        PG8_STAGE(PG8_SB(1, 0), cB + kstep, voffB); PG8_STAGE(PG8_SA(1, 0), cA + kstep, voffA); PG8_STAGE(PG8_SB(1, 1), cB + hstep + kstep, voffB);
        PG8_WAIT_V(6); PG8_BAR;
    } else {
        PG8_STAGE(PG8_SB(0, 0), cB, voffB); PG8_STAGE(PG8_SA(0, 0), cA, voffA); PG8_STAGE(PG8_SB(0, 1), cB + hstep, voffB); PG8_STAGE(PG8_SA(0, 1), cA + hstep, voffA);
        if (wr == 1) PG8_BAR;
        PG8_WAIT_V(4); PG8_BAR;
        PG8_STAGE(PG8_SB(1, 0), cB + kstep, voffB); PG8_STAGE(PG8_SA(1, 0), cA + kstep, voffA); PG8_STAGE(PG8_SB(1, 1), cB + hstep + kstep, voffB);
        PG8_WAIT_V(6); PG8_BAR;
    }
    for (;;) {
        const bool has_next = S.next(ui + 1, nxt);
        const char* nA = has_next ? (const char*)g.A + (size_t)nxt.pm * tstep : cA; const char* nB = has_next ? (const char*)g.Bt + (size_t)nxt.pn * tstep : cB;
        for (int t = 0; t < nt; t += 2) {
            const bool last = (t == nt - 2);
            const char* a1 = cA + (size_t)(t + 1) * kstep;
            const char* a2 = last ? nA : cA + (size_t)(t + 2) * kstep; const char* b2 = last ? nB : cB + (size_t)(t + 2) * kstep;
            const char* a3 = a2 + kstep; const char* b3 = b2 + kstep;
            if (last && has_next) S.a_ready(nxt);
            if constexpr (SP2) {
            PG8_LDB(B0, 0, 0); PG8_LDB(B1, 0, 1); PG8_SCHED; PG8_LDA(At, 0, 0); PG8_STAGE(PG8_SA(1, 1), a1 + hstep, voffA);
            PG8_WAIT_V(8); PG8_WAIT_L(0); PG8_BAR; PG8_MMA(0, 0, At, B0); PG8_MMA(0, 1, At, B1); PG8_BAR; PG8_SCHED;
            PG8_LDA(At, 0, 1); PG8_STAGE(PG8_SB(0, 0), b2, voffB); PG8_STAGE(PG8_SB(0, 1), b2 + hstep, voffB); PG8_STAGE(PG8_SA(0, 0), a2, voffA);
            PG8_WAIT_V(8); PG8_WAIT_L(0); PG8_BAR; PG8_MMA(1, 0, At, B0); PG8_MMA(1, 1, At, B1); PG8_BAR; PG8_SCHED;
            PG8_LDB(B0, 1, 0); PG8_LDB(B1, 1, 1); PG8_SCHED; PG8_LDA(At, 1, 0); PG8_STAGE(PG8_SA(0, 1), a2 + hstep, voffA);
            PG8_WAIT_V(8); PG8_WAIT_L(0); PG8_BAR; PG8_MMA(0, 0, At, B0); PG8_MMA(0, 1, At, B1); PG8_BAR; PG8_SCHED;
            PG8_LDA(At, 1, 1); PG8_STAGE(PG8_SB(1, 0), b3, voffB); PG8_STAGE(PG8_SB(1, 1), b3 + hstep, voffB); PG8_STAGE(PG8_SA(1, 0), a3, voffA);
            PG8_WAIT_V(8); PG8_WAIT_L(0); PG8_BAR; PG8_MMA(1, 0, At, B0); PG8_MMA(1, 1, At, B1); PG8_BAR; PG8_SCHED;
            } else {
            PG8_LDB(B0, 0, 0); PG8_SCHED; PG8_LDA(At, 0, 0); PG8_STAGE(PG8_SA(1, 1), a1 + hstep, voffA);
            PG8_WAIT_L(8); PG8_BAR; PG8_WAIT_L(0); PG8_MMA(0, 0, At, B0); PG8_BAR; PG8_SCHED;
            PG8_LDB(B1, 0, 1); PG8_STAGE(PG8_SB(0, 0), b2, voffB);
            PG8_BAR; PG8_WAIT_L(0); PG8_MMA(0, 1, At, B1); PG8_BAR;
            PG8_LDA(At, 0, 1); PG8_STAGE(PG8_SA(0, 0), a2, voffA);
            PG8_BAR; PG8_WAIT_L(0); PG8_MMA(1, 0, At, B0); PG8_BAR; PG8_SCHED;
            PG8_STAGE(PG8_SB(0, 1), b2 + hstep, voffB);
            PG8_WAIT_V(6); PG8_BAR; PG8_MMA(1, 1, At, B1); PG8_BAR;
            PG8_LDB(B0, 1, 0); PG8_SCHED; PG8_LDA(At, 1, 0); PG8_STAGE(PG8_SA(0, 1), a2 + hstep, voffA);
            PG8_WAIT_L(8); PG8_BAR; PG8_WAIT_L(0); PG8_MMA(0, 0, At, B0); PG8_BAR; PG8_SCHED;
            PG8_LDB(B1, 1, 1); PG8_STAGE(PG8_SB(1, 0), b3, voffB);
            PG8_BAR; PG8_WAIT_L(0); PG8_MMA(0, 1, At, B1); PG8_BAR;
            PG8_LDA(At, 1, 1); PG8_STAGE(PG8_SA(1, 0), a3, voffA);
            PG8_BAR; PG8_WAIT_L(0); PG8_MMA(1, 0, At, B0); PG8_BAR; PG8_SCHED;
            PG8_STAGE(PG8_SB(1, 1), b3 + hstep, voffB);
            PG8_WAIT_V(6); PG8_BAR; PG8_MMA(1, 1, At, B1); PG8_BAR;
            }
        }
        if constexpr (ALIGN_EPI) { if (wr == 0) PG8_BAR; }
        if constexpr (!Epi::AFTER_DRAIN) { E(acc, cur, wr, wc, fr, fq); S.done(cur); }
        if (!has_next) break;
#pragma unroll
        for (int a = 0; a < 2; ++a)
#pragma unroll
            for (int b = 0; b < 2; ++b)
#pragma unroll
                for (int m = 0; m < 4; ++m)
#pragma unroll
                    for (int n = 0; n < 2; ++n) acc[a][b][m][n] = (f32x4){0.f, 0.f, 0.f, 0.f};
        cur = nxt; cA = nA; cB = nB; ++ui;
        if constexpr (ALIGN_EPI) { if (wr == 1) PG8_BAR; }
    }
    PG8_WAIT_V(0);
    if constexpr (!ALIGN_EPI) { if (wr == 0) PG8_BAR; }
    PG8_BAR;
    if constexpr (Epi::AFTER_DRAIN) { E.fused(acc, cur, wr, wc, fr, fq, lds, wid, lane); S.done(cur); }
#undef PG8_SA
#undef PG8_SB
#undef PG8_STAGE
#undef PG8_LDA
#undef PG8_LDB
#undef PG8_MMA
#undef PG8_WAIT_V
#undef PG8_WAIT_L
#undef PG8_BAR
#undef PG8_SCHED
}
}
namespace att {
typedef __hip_bfloat16 bf16;
typedef __attribute__((ext_vector_type(8))) short bf16x8;
typedef __attribute__((ext_vector_type(4))) short s16x4;
typedef __attribute__((ext_vector_type(16))) float f32x16;
typedef __attribute__((ext_vector_type(4))) float f32x4;
typedef __attribute__((ext_vector_type(4))) unsigned u32x4;
typedef __attribute__((ext_vector_type(2))) unsigned u32x2;
#define ALAS __attribute__((address_space(3)))
constexpr int PITCH = 2048, SEQ = 2048, D = 64, QB = 256, KVB = 64, NQB = SEQ / QB;
constexpr int SLOTB = 16384, NSLOT = 3;
constexpr int L_CUM = NSLOT * SLOTB, L_WSF = L_CUM + SEQ * 4, L_OST = L_WSF + 8 * 256, L_END = L_OST + 8 * 8192;
constexpr float C2 = 0.125f * 1.4426950408889634f;
__device__ __forceinline__ int crow(int r, int hi) { return (r & 3) + 8 * (r >> 2) + 4 * hi; }
__device__ __forceinline__ void glds16(const void* gsrc, unsigned lds_dst) { unsigned keep;
  asm volatile("s_mov_b32 %0, m0\n\ts_mov_b32 m0, %2\n\ts_nop 0\n\tglobal_load_lds_dwordx4 %1, off\n\ts_mov_b32 m0, %0" : "=&s"(keep) : "v"(gsrc), "s"(lds_dst) : "memory"); }
typedef float f32x2_t __attribute__((ext_vector_type(2))); typedef __bf16 bf16x2_t __attribute__((ext_vector_type(2)));
__device__ __forceinline__ unsigned cvtpk(float lo, float hi) { f32x2_t v = {lo, hi}; bf16x2_t b = __builtin_convertvector(v, bf16x2_t); return __builtin_bit_cast(unsigned, b); }
typedef short v4i16_t __attribute__((ext_vector_type(4)));
__device__ __forceinline__ s16x4 vtr(const ALAS char* p) { return __builtin_bit_cast(s16x4, __builtin_amdgcn_ds_read_tr16_b64_v4i16((ALAS v4i16_t*)p)); }
__device__ __forceinline__ float swap_sum(float v) { auto rr = __builtin_amdgcn_permlane32_swap(__float_as_uint(v), __float_as_uint(v), false, false); return __uint_as_float(rr[0]) + __uint_as_float(rr[1]); }
__device__ __forceinline__ float swap_max(float v) { auto rr = __builtin_amdgcn_permlane32_swap(__float_as_uint(v), __float_as_uint(v), false, false); return fmaxf(__uint_as_float(rr[0]), __uint_as_float(rr[1])); }
#define AWAIT_BAR(N) asm volatile("s_waitcnt vmcnt(" #N ") lgkmcnt(0)\n\ts_barrier" ::: "memory")

struct St { f32x16 o0, o1; float mhat, l, R; };

__device__ __forceinline__ void qkt(f32x16& p0, f32x16& p1, const ALAS char* kp, const bf16x8* qr, const f32x16& c0, const f32x16& c1) {
#pragma unroll
  for (int d0 = 0; d0 < 4; ++d0) {
    const bf16x8 b0 = *(const ALAS bf16x8*)(kp + d0 * 2048);
    const bf16x8 b1 = *(const ALAS bf16x8*)(kp + d0 * 2048 + 512);
    if (d0 == 0) { p0 = __builtin_amdgcn_mfma_f32_32x32x16_bf16(b0, qr[0], c0, 0, 0, 0); p1 = __builtin_amdgcn_mfma_f32_32x32x16_bf16(b1, qr[0], c1, 0, 0, 0); }
    else { p0 = __builtin_amdgcn_mfma_f32_32x32x16_bf16(b0, qr[d0], p0, 0, 0, 0); p1 = __builtin_amdgcn_mfma_f32_32x32x16_bf16(b1, qr[d0], p1, 0, 0, 0); }
  }
}
__device__ __forceinline__ void pv(St& s, const ALAS char* vp, const f32x16& p0, const f32x16& p1) {
  u32x4 pw[4];
  pw[0] = (u32x4){cvtpk(p0[0], p0[1]), cvtpk(p0[2], p0[3]), cvtpk(p0[4], p0[5]), cvtpk(p0[6], p0[7])};
  pw[1] = (u32x4){cvtpk(p0[8], p0[9]), cvtpk(p0[10], p0[11]), cvtpk(p0[12], p0[13]), cvtpk(p0[14], p0[15])};
  pw[2] = (u32x4){cvtpk(p1[0], p1[1]), cvtpk(p1[2], p1[3]), cvtpk(p1[4], p1[5]), cvtpk(p1[6], p1[7])};
  pw[3] = (u32x4){cvtpk(p1[8], p1[9]), cvtpk(p1[10], p1[11]), cvtpk(p1[12], p1[13]), cvtpk(p1[14], p1[15])};
#pragma unroll
  for (int ks = 0; ks < 4; ++ks) {
    const s16x4 a0 = vtr(vp + ks * 1024), a1 = vtr(vp + ks * 1024 + 512), b0 = vtr(vp + 4096 + ks * 1024), b1 = vtr(vp + 4096 + ks * 1024 + 512);
    const bf16x8 v0 = (bf16x8){a0[0], a0[1], a0[2], a0[3], a1[0], a1[1], a1[2], a1[3]};
    const bf16x8 v1 = (bf16x8){b0[0], b0[1], b0[2], b0[3], b1[0], b1[1], b1[2], b1[3]};
    s.o0 = __builtin_amdgcn_mfma_f32_32x32x16_bf16(__builtin_bit_cast(bf16x8, pw[ks]), v0, s.o0, 0, 0, 0);
    s.o1 = __builtin_amdgcn_mfma_f32_32x32x16_bf16(__builtin_bit_cast(bf16x8, pw[ks]), v1, s.o1, 0, 0, 0);
  }
}

template <bool DIAG, bool FIRST>
__device__ __forceinline__ void fox_tile(St& s, const ALAS char* kp, const ALAS char* vp, const bf16x8* qr, const ALAS float* ck, float cq2, int jb, int qrel, int hi, int r32, ALAS float* wsf) {
  f32x16 c0, c1; const float cb = cq2 - s.mhat;
#pragma unroll
  for (int g = 0; g < 4; ++g) { const f32x4 a = *(const ALAS f32x4*)(ck + 8 * g + 4 * hi), b = *(const ALAS f32x4*)(ck + 32 + 8 * g + 4 * hi);
#pragma unroll
    for (int i = 0; i < 4; ++i) { c0[4 * g + i] = cb - a[i]; c1[4 * g + i] = cb - b[i]; } }
  f32x16 p0, p1; qkt(p0, p1, kp, qr, c0, c1);
  if (DIAG) {
    const float U = ((float)(qrel - 64 * jb - 4 * hi) + 0.5f) * 0x1p100f;
#pragma unroll
    for (int r = 0; r < 16; ++r) { const float c = (float)((r & 3) + 8 * (r >> 2)); p0[r] = fminf(p0[r], U - c * 0x1p100f); p1[r] = fminf(p1[r], U - (c + 32.0f) * 0x1p100f); }
  }
  float a = fmaxf(p0[0], p1[0]);
#pragma unroll
  for (int r = 1; r < 16; ++r) a = fmaxf(a, fmaxf(p0[r], p1[r]));
  const float rm = swap_max(a);
  if (FIRST) {
    s.mhat += rm;
#pragma unroll
    for (int r = 0; r < 16; ++r) { p0[r] -= rm; p1[r] -= rm; }
  } else if (__any(rm > 8.0f)) {
    const float dl = fmaxf(rm, 0.f); s.mhat += dl;
#pragma unroll
    for (int r = 0; r < 16; ++r) { p0[r] -= dl; p1[r] -= dl; }
    const float f = __builtin_amdgcn_exp2f(-dl); s.l *= f;
    if (hi == 0) wsf[r32] = f;
    asm volatile("s_waitcnt lgkmcnt(0)" ::: "memory");
#pragma unroll
    for (int r = 0; r < 16; ++r) { const float fr_ = wsf[crow(r, hi)]; s.o0[r] *= fr_; s.o1[r] *= fr_; }
    asm volatile("s_waitcnt lgkmcnt(0)" ::: "memory");
  }
  float sum = 0.f;
#pragma unroll
  for (int r = 0; r < 16; ++r) { p0[r] = __builtin_amdgcn_exp2f(p0[r]); p1[r] = __builtin_amdgcn_exp2f(p1[r]); sum += p0[r] + p1[r]; }
  s.l += sum;
  pv(s, vp, p0, p1);
}

template <bool DIAG>
__device__ __forceinline__ void sb_tile(St& s, const ALAS char* kp, const ALAS char* vp, const bf16x8* qr, int jb, int qrel, int hi) {
  f32x16 p0, p1; const f32x16 z = {};
  qkt(p0, p1, kp, qr, z, z);
  if (DIAG) {
    const float U = ((float)(qrel - 64 * jb - 4 * hi) - 0.5f) * 0x1p100f;
#pragma unroll
    for (int r = 0; r < 16; ++r) { const float c = (float)((r & 3) + 8 * (r >> 2)); p0[r] = fminf(p0[r], U - c * 0x1p100f); p1[r] = fminf(p1[r], U - (c + 32.0f) * 0x1p100f); }
  }
#pragma unroll
  for (int r = 0; r < 16; ++r) {
    const float e0 = __builtin_amdgcn_exp2f(fminf(p0[r], 126.f)), e1 = __builtin_amdgcn_exp2f(fminf(p1[r], 126.f));
    p0[r] = __builtin_amdgcn_rcpf(1.0f + e0); p1[r] = __builtin_amdgcn_rcpf(1.0f + e1);
  }
  float Y = s.R;
#pragma unroll
  for (int j = 0; j < 8; ++j) {
    const int g = (j < 4) ? (3 - j) : (7 - j);
    f32x16& P = (j < 4) ? p1 : p0;
    const float k0 = P[4 * g], k1 = P[4 * g + 1], k2 = P[4 * g + 2], k3 = P[4 * g + 3];
    const float t1 = k3 * k2, t0 = t1 * k1, G = t0 * k0;
    auto rr = __builtin_amdgcn_permlane32_swap(__float_as_uint(G), __float_as_uint(G), false, false);
    const float Go = __uint_as_float(rr[0]), Ge = __uint_as_float(rr[1]);
    const float Y1 = Y * Ge, Y2 = Y1 * Go;
    const float X = hi ? Y : Y1, XG = hi ? Y1 : Y2;
    const float pe2 = X * k3, pe1 = X * t1, pe0 = X * t0;
    P[4 * g + 3] = X - pe2; P[4 * g + 2] = pe2 - pe1; P[4 * g + 1] = pe1 - pe0; P[4 * g] = pe0 - XG;
    Y = Y2;
  }
  s.R = Y;
  pv(s, vp, p0, p1);
}

template <int MODE>
__device__ __forceinline__ void unit(int tok0, int h, int qb, const bf16* Q, const bf16* K, const bf16* V, const bf16* Z, bf16* O, ALAS char* shm3) {
  int tid_ = threadIdx.x; asm volatile("" : "+v"(tid_));
  const int tid = tid_, lane = tid & 63, r32 = lane & 31, hi = lane >> 5; const int wid = __builtin_amdgcn_readfirstlane(tid >> 6);
  const int q0 = qb * QB;
  const bf16* Qw = Q + (size_t)(tok0 + q0 + wid * 32) * PITCH + h * D;
  const bf16* Kh = K + (size_t)tok0 * PITCH + h * D; const bf16* Vh = V + (size_t)tok0 * PITCH + h * D;
  const unsigned lds0 = (unsigned)(uintptr_t)shm3;
  ALAS float* wsf = (ALAS float*)(shm3 + L_WSF) + wid * 64;
  const ALAS float* cum = (const ALAS float*)(shm3 + L_CUM);
  const bf16* ksrc = Kh + (size_t)lane * PITCH + wid * 8;
  const bf16* vsrc = Vh + (size_t)(16 * (wid & 3) + (lane >> 2)) * PITCH + (wid >> 2) * 32 + (lane & 3) * 8;
  const unsigned kdst = lds0 + wid * 1024, vdst = lds0 + 8192 + wid * 1024;
#define DMA_KV(jt, slot) do { glds16(ksrc + (size_t)(jt) * KVB * PITCH, (unsigned)__builtin_amdgcn_readfirstlane(kdst + (slot) * SLOTB)); \
                              glds16(vsrc + (size_t)(jt) * KVB * PITCH, (unsigned)__builtin_amdgcn_readfirstlane(vdst + (slot) * SLOTB)); } while (0)
  const int NT = 4 * qb + 4;
  DMA_KV(NT - 1, 0); DMA_KV(NT - 2, 1);
  bf16x8 qr[4];
#pragma unroll
  for (int d0 = 0; d0 < 4; ++d0) qr[d0] = *(const bf16x8*)(Qw + (size_t)r32 * PITCH + d0 * 16 + hi * 8);
  St s; s.o0 = f32x16{}; s.o1 = f32x16{}; s.mhat = 0.f; s.l = 0.f; s.R = 1.0f;
  const int qrel = wid * 32 + r32; const int jd = 4 * qb + (wid >> 1);
  float cq2 = 0.f; if (MODE == 0) cq2 = cum[q0 + qrel];
  const ALAS char* kp0 = shm3 + hi * 1024 + r32 * 16;
  const ALAS char* vp0 = shm3 + 8192 + ((lane >> 4) & 1) * 32 + (lane & 3) * 8 + (4 * hi + ((lane & 15) >> 2)) * 64;
  AWAIT_BAR(0);
  int slot = 0;
  for (int i = 0; i < NT; ++i) {
    const int jt = NT - 1 - i;
    const bool more = (i + 2 < NT);
    if (more) { const int s2 = (slot + 2 >= NSLOT) ? slot + 2 - NSLOT : slot + 2; DMA_KV(jt - 2, s2); }
    if (jt <= jd) {
      const ALAS char* kp = kp0 + slot * SLOTB; const ALAS char* vp = vp0 + slot * SLOTB;
      if (MODE == 0) {
        if (jt == jd) fox_tile<true, true>(s, kp, vp, qr, cum + 64 * jt, cq2, jt - 4 * qb, qrel, hi, r32, wsf);
        else fox_tile<false, false>(s, kp, vp, qr, cum + 64 * jt, cq2, 0, qrel, hi, r32, wsf);
      } else {
        if (jt == jd) sb_tile<true>(s, kp, vp, qr, jt - 4 * qb, qrel, hi);
        else sb_tile<false>(s, kp, vp, qr, 0, qrel, hi);
      }
    }
    if (more) AWAIT_BAR(2); else AWAIT_BAR(0);
    slot = (slot + 1 >= NSLOT) ? 0 : slot + 1;
  }
#undef DMA_KV
  if (MODE == 0) {
    const float lt = swap_sum(s.l); const float inv = __builtin_amdgcn_rcpf(lt);
    if (hi == 0) wsf[r32] = inv;
    asm volatile("s_waitcnt lgkmcnt(0)" ::: "memory");
#pragma unroll
    for (int r = 0; r < 16; ++r) { const float f = wsf[crow(r, hi)]; s.o0[r] *= f; s.o1[r] *= f; }
  }
  ALAS float* stg = (ALAS float*)(shm3 + L_OST + wid * 8192);
#pragma unroll
  for (int r = 0; r < 16; ++r) { const int orow = crow(r, hi); stg[orow * 64 + r32] = s.o0[r]; stg[orow * 64 + 32 + r32] = s.o1[r]; }
  asm volatile("s_waitcnt lgkmcnt(0)" ::: "memory");
  const bf16* Zw = Z + (size_t)(tok0 + q0 + wid * 32) * PITCH + h * D;
  bf16* Ow = O + (size_t)(tok0 + q0 + wid * 32) * PITCH + h * D;
#pragma unroll
  for (int i = 0; i < 4; ++i) {
    const int row = i * 8 + (lane >> 3), ch = lane & 7;
    const u32x4 zz = *(const u32x4*)(Zw + (size_t)row * PITCH + ch * 8);
    const f32x4 a = *(const ALAS f32x4*)(stg + row * 64 + ch * 8), b = *(const ALAS f32x4*)(stg + row * 64 + ch * 8 + 4);
    float ov[8] = {a[0], a[1], a[2], a[3], b[0], b[1], b[2], b[3]};
    unsigned w[4];
#pragma unroll
    for (int e = 0; e < 4; ++e) {
      const float z0 = __uint_as_float(zz[e] << 16), z1 = __uint_as_float(zz[e] & 0xffff0000u);
      const float g0 = z0 * __builtin_amdgcn_rcpf(1.0f + __builtin_amdgcn_exp2f(-1.4426950408889634f * z0));
      const float g1 = z1 * __builtin_amdgcn_rcpf(1.0f + __builtin_amdgcn_exp2f(-1.4426950408889634f * z1));
      w[e] = cvtpk(ov[2 * e] * g0, ov[2 * e + 1] * g1);
    }
    *(u32x4*)(Ow + (size_t)row * PITCH + ch * 8) = (u32x4){w[0], w[1], w[2], w[3]};
  }
  asm volatile("s_waitcnt lgkmcnt(0)" ::: "memory");
}
}
constexpr int NWAVES = 8;
constexpr int DM = 1024, NB = 32, SEQ = 2048, MTOK = NB * SEQ, DI = 2048, NH = 32;
constexpr int NCHUNK = 2, CH = MTOK / NCHUNK, CHB = NB / NCHUNK;
constexpr int NIN0 = 8448, NIN0_REAL = 8224, NIN1 = 8192;
constexpr float NORM_EPS = 1e-6f;
constexpr size_t MiB = 1u << 20;
constexpr size_t WS_WIN0 = 0, WS_WIN1 = 17 * MiB, WS_WOUT0 = 33 * MiB, WS_WOUT1 = 37 * MiB, WS_MOD = 41 * MiB, WS_LOGF = 42 * MiB, WS_H = 46 * MiB, WS_Q = 110 * MiB;
constexpr size_t QKVZ_STRIDE = (size_t)CH * DI;
constexpr size_t WS_END = WS_Q + 4 * QKVZ_STRIDE * 2;
static_assert((size_t)NIN0 * DM * 2 <= WS_WIN1 && (size_t)CH * 32 * 4 <= WS_H - WS_LOGF && (size_t)CH * DM * 2 <= WS_Q - WS_H, "d_ws map");
constexpr int RING_BYTES = 131072, LDS_BYTES = 147456;
static_assert(att::L_END <= RING_BYTES, "attention LDS map");
#define GAS __attribute__((address_space(1)))
#define LAS __attribute__((address_space(3)))
typedef unsigned short bf16raw;
typedef unsigned v4u __attribute__((ext_vector_type(4)));
typedef float f32x4 __attribute__((ext_vector_type(4)));
#define LDS_WAIT() asm volatile("s_waitcnt lgkmcnt(0)" ::: "memory")
__device__ __forceinline__ unsigned f2bf(float f) { unsigned u = __builtin_bit_cast(unsigned, f); return (u + 0x7fffu + ((u >> 16) & 1u)) >> 16; }
__device__ __forceinline__ unsigned pk2(float lo, float hi) { return f2bf(lo) | (f2bf(hi) << 16); }
__device__ __forceinline__ float wave_sum(float v) {
#pragma unroll
    for (int o = 1; o < 64; o <<= 1) v += __shfl_xor(v, o);
    return v;
}
struct Params { const float *x, *c, *fng, *fwada, *fbada, *fwin, *fbf, *fwout, *sng, *swada, *sbada, *swin, *swout, *fing; float* out; unsigned char* ws; };

__device__ __forceinline__ void transpose_item(const float* W, int K, int N, bf16raw* WT, LAS float* scr, int item, int lane) {
    const int nblk = N / 32, kb = item / nblk, nb = item % nblk, k0 = 64 * kb, n0 = 32 * nb;
#pragma unroll 8
    for (int i = 0; i < 32; ++i) { const int kk = 2 * i + (lane >> 5); scr[kk * 33 + (lane & 31)] = W[(size_t)(k0 + kk) * N + n0 + (lane & 31)]; }
    LDS_WAIT(); asm volatile("" ::: "memory");
    const int c = lane & 7;
#pragma unroll
    for (int j = 0; j < 4; ++j) { const int n = (lane >> 3) + 8 * j; const LAS float* s = scr + (8 * c) * 33 + n;
        v4u o; o.x = pk2(s[0 * 33], s[1 * 33]); o.y = pk2(s[2 * 33], s[3 * 33]); o.z = pk2(s[4 * 33], s[5 * 33]); o.w = pk2(s[6 * 33], s[7 * 33]);
        *(v4u*)(WT + (size_t)(n0 + n) * K + k0 + 8 * c) = o; }
    LDS_WAIT(); asm volatile("" ::: "memory");
}

__device__ __forceinline__ void ada_item(const float* c, const float* W, const float* bias, float* mod, int cb, LAS unsigned char* lds, int tid) {
    const int lane = tid & 63, wave = tid >> 6;
    LAS float* sc = (LAS float*)lds + wave * 4096;
    for (int i = lane; i < 4096; i += 64) { const int b = i >> 7, kk = i & 127; const float v = c[b * DM + wave * 128 + kk]; sc[i] = v / (1.0f + __expf(-v)); }
    LDS_WAIT(); asm volatile("" ::: "memory");
    float acc[32];
#pragma unroll
    for (int b = 0; b < 32; ++b) acc[b] = 0.f;
    const float* Wp = W + (size_t)(wave * 128) * 3072 + cb * 64 + lane;
    for (int kk = 0; kk < 128; kk += 4) {
        const float w0 = Wp[(size_t)(kk + 0) * 3072], w1 = Wp[(size_t)(kk + 1) * 3072], w2 = Wp[(size_t)(kk + 2) * 3072], w3 = Wp[(size_t)(kk + 3) * 3072];
#pragma unroll
        for (int b = 0; b < 32; ++b) { const f32x4 s4 = *(const LAS f32x4*)(sc + b * 128 + kk); acc[b] += s4[0] * w0 + s4[1] * w1 + s4[2] * w2 + s4[3] * w3; }
    }
    __syncthreads();
    LAS float* red = (LAS float*)lds;
#pragma unroll
    for (int b = 0; b < 32; ++b) red[(wave * 32 + b) * 64 + lane] = acc[b];
    __syncthreads();
    for (int o = tid; o < 2048; o += 512) { const int b = o >> 6, col = o & 63; float sacc = 0.f;
#pragma unroll
        for (int w = 0; w < 8; ++w) sacc += red[(w * 32 + b) * 64 + col];
        mod[(size_t)b * 3072 + cb * 64 + col] = sacc + bias[cb * 64 + col]; }
    __syncthreads();
}

__device__ __forceinline__ void norm_rows(const float* src, const float* g, const float* mod, bf16raw* H, int grow0, int lrow0, int nrows, int lane) {
    const int b = grow0 >> 11;
    f32x4 mul[4], add[4];
#pragma unroll
    for (int j = 0; j < 4; ++j) { const f32x4 gg = *(const f32x4*)(g + 4 * lane + 256 * j), sc = *(const f32x4*)(mod + (size_t)b * 3072 + 1024 + 4 * lane + 256 * j);
        mul[j] = gg * (sc + 1.0f); add[j] = *(const f32x4*)(mod + (size_t)b * 3072 + 4 * lane + 256 * j); }
    for (int r = 0; r < nrows; ++r) {
        const f32x4* xr = (const f32x4*)(src + (size_t)(grow0 + r) * DM) + lane;
        f32x4 v[4]; float s = 0.f;
#pragma unroll
        for (int j = 0; j < 4; ++j) { v[j] = xr[64 * j]; s += (v[j].x * v[j].x + v[j].y * v[j].y) + (v[j].z * v[j].z + v[j].w * v[j].w); }
        const float rstd = 1.0f / sqrtf(wave_sum(s) * (1.0f / DM) + NORM_EPS);
        unsigned long long* o8 = (unsigned long long*)(H + (size_t)(lrow0 + r) * DM) + lane;
#pragma unroll
        for (int j = 0; j < 4; ++j) { const f32x4 y = v[j] * rstd * mul[j] + add[j];
            o8[64 * j] = (unsigned long long)pk2(y.x, y.y) | ((unsigned long long)pk2(y.z, y.w) << 32); }
    }
}
__device__ __forceinline__ void final_norm_rows(float* out, const float* g, int row0, int nrows, int lane) {
    f32x4 mul[4];
#pragma unroll
    for (int j = 0; j < 4; ++j) mul[j] = *(const f32x4*)(g + 4 * lane + 256 * j);
    for (int r = 0; r < nrows; ++r) {
        f32x4* xr = (f32x4*)(out + (size_t)(row0 + r) * DM) + lane;
        f32x4 v[4]; float s = 0.f;
#pragma unroll
        for (int j = 0; j < 4; ++j) { v[j] = xr[64 * j]; s += (v[j].x * v[j].x + v[j].y * v[j].y) + (v[j].z * v[j].z + v[j].w * v[j].w); }
        const float rstd = 1.0f / sqrtf(wave_sum(s) * (1.0f / DM) + NORM_EPS);
#pragma unroll
        for (int j = 0; j < 4; ++j) xr[64 * j] = v[j] * rstd * mul[j];
    }
}

__device__ __forceinline__ void cumsum_to_lds(const float* lf, int tok0, int h, LAS unsigned char* lds, int tid) {
    LAS float* cum = (LAS float*)(lds + att::L_CUM); LAS float* tot = (LAS float*)(lds + att::L_WSF);
    __syncthreads();
    const int lane = tid & 63, wave = tid >> 6;
    const float* p = lf + (size_t)(tok0 + 4 * tid) * 32 + h;
    float a0 = p[0], a1 = p[32], a2 = p[64], a3 = p[96];
    a1 += a0; a2 += a1; a3 += a2;
    float inc = a3;
#pragma unroll
    for (int o = 1; o < 64; o <<= 1) { const float t = __shfl_up(inc, o); if (lane >= o) inc += t; }
    if (lane == 63) tot[wave] = inc;
    __syncthreads();
    float base = inc - a3;
    for (int w = 0; w < wave; ++w) base += tot[w];
    *(LAS f32x4*)(cum + 4 * tid) = (f32x4){a0 + base, a1 + base, a2 + base, a3 + base};
    __syncthreads();
}

#define CAS __attribute__((address_space(4)))
__device__ __forceinline__ const CAS Params* launder(const CAS Params* q) { asm volatile("" : "+s"(q)); return q; }
#define PP (launder(kp0))
__global__ void __launch_bounds__(NWAVES * 64) mega_fwd(Params p_kernarg) {
    const CAS Params* const kp0 = (const CAS Params*)__builtin_amdgcn_kernarg_segment_ptr();
    extern __shared__ __attribute__((aligned(16))) unsigned char lds_raw[];
    cg::grid_group grid = cg::this_grid();
    LAS unsigned char* lds = (LAS unsigned char*)lds_raw;
    const int tid = threadIdx.x, lane = tid & 63, wave = __builtin_amdgcn_readfirstlane(tid >> 6);
    const int G = gridDim.x, bx = blockIdx.x; const int vcu = (G % 8 == 0) ? (bx % 8) * (G / 8) + bx / 8 : bx;
#define WIN_T(l) ((bf16raw*)(PP->ws + ((l) ? WS_WIN1 : WS_WIN0)))
#define WOUT_T(l) ((bf16raw*)(PP->ws + ((l) ? WS_WOUT1 : WS_WOUT0)))
#define MOD_ ((float*)(PP->ws + WS_MOD))
#define LF_ ((float*)(PP->ws + WS_LOGF))
#define H_ ((bf16raw*)(PP->ws + WS_H))
#define QB_ ((bf16raw*)(PP->ws + WS_Q))

    {
        LAS float* scr = (LAS float*)(lds + wave * 16384);
        const int gw = vcu * NWAVES + wave, NGW = G * NWAVES;
        constexpr int I_IN0 = 16 * (NIN0_REAL / 32), I_IN1 = 16 * (NIN1 / 32), I_OUT = 32 * 32;
        constexpr int NITEMS = I_IN0 + I_IN1 + 2 * I_OUT;
        for (int it = gw; it < NITEMS; it += NGW) {
            int r = it;
            if (r < I_IN0) { transpose_item(PP->fwin, DM, NIN0_REAL, WIN_T(0), scr, r, lane); continue; } r -= I_IN0;
            if (r < I_IN1) { transpose_item(PP->swin, DM, NIN1, WIN_T(1), scr, r, lane); continue; } r -= I_IN1;
            if (r < I_OUT) { transpose_item(PP->fwout, DI, DM, WOUT_T(0), scr, r, lane); continue; } r -= I_OUT;
            transpose_item(PP->swout, DI, DM, WOUT_T(1), scr, r, lane);
        }
        { v4u* z = (v4u*)(WIN_T(0) + (size_t)NIN0_REAL * DM); const int n16 = (NIN0 - NIN0_REAL) * DM * 2 / 16;
          for (int i = bx * 512 + tid; i < n16; i += G * 512) z[i] = (v4u){0u, 0u, 0u, 0u}; }
        __syncthreads();
        for (int it = bx; it < 96; it += G) { const int l = it / 48, cb = it % 48;
            ada_item(PP->c, l ? PP->swada : PP->fwada, l ? PP->sbada : PP->fbada, MOD_ + (size_t)l * NB * 3072, cb, lds, tid); }
    }
    grid.sync();
    const int rows_per_wave = CH / (G * NWAVES);
#define NORM_PHASE(l, ch) do { const int lr0 = (vcu * NWAVES + wave) * rows_per_wave; \
        norm_rows((l) ? PP->out : PP->x, (l) ? PP->sng : PP->fng, MOD_ + (size_t)(l) * NB * 3072, H_, (ch) * CH + lr0, lr0, rows_per_wave, lane); } while (0)
    NORM_PHASE(0, 0);
    grid.sync();
    auto layer_chunk = [&](auto LC, auto CC) __attribute__((always_inline)) {
        constexpr int l = decltype(LC)::value, ch = decltype(CC)::value;
            {
                pg8::Gemm g{H_, WIN_T(l), CH, l ? NIN1 : NIN0, DM}; pg8::StaticOrder S; S.init(CH, l ? NIN1 : NIN0, G, bx);
                pg8::EpiProj E{QB_, QKVZ_STRIDE, att::C2, LF_, PP->fbf};
                pg8::gemm_phase<pg8::EpiProj, pg8::StaticOrder, true, true>(lds, g, S, E);
            }
            grid.sync();
            {
                const att::bf16* Qp = (const att::bf16*)QB_; const att::bf16* Kp = Qp + QKVZ_STRIDE; const att::bf16* Vp = Kp + QKVZ_STRIDE; const att::bf16* Zp = Vp + QKVZ_STRIDE;
                for (int bh = vcu; bh < CHB * NH; bh += G) {
                    const int b = bh / NH, h = bh % NH, tok0 = b * SEQ;
                    if (l == 0) { cumsum_to_lds(LF_, tok0, h, lds, tid);
                        for (int qb = att::NQB - 1; qb >= 0; --qb) att::unit<0>(tok0, h, qb, Qp, Kp, Vp, Zp, (att::bf16*)QB_, (LAS char*)lds); }
                    else { for (int qb = att::NQB - 1; qb >= 0; --qb) att::unit<1>(tok0, h, qb, Qp, Kp, Vp, Zp, (att::bf16*)QB_, (LAS char*)lds); }
                }
                asm volatile("s_waitcnt vmcnt(0) lgkmcnt(0)" ::: "memory"); __syncthreads();
            }
            grid.sync();
            {
                pg8::Gemm g{QB_, WOUT_T(l), CH, DM, DI}; pg8::StaticOrder S; S.init(CH, DM, G, bx);
                pg8::EpiRes E{l ? PP->out : PP->x, PP->out, MOD_ + (size_t)l * NB * 3072 + 2048, ch * CH};
                pg8::gemm_phase<pg8::EpiRes, pg8::StaticOrder, true, true>(lds, g, S, E);
            }
            if (ch + 1 < NCHUNK) NORM_PHASE(l, ch + 1);
            else if (l == 0) NORM_PHASE(1, 0);
            grid.sync();
    };
    layer_chunk(std::integral_constant<int, 0>{}, std::integral_constant<int, 0>{});
    layer_chunk(std::integral_constant<int, 0>{}, std::integral_constant<int, 1>{});
    layer_chunk(std::integral_constant<int, 1>{}, std::integral_constant<int, 0>{});
    layer_chunk(std::integral_constant<int, 1>{}, std::integral_constant<int, 1>{});
    { const int rpw = MTOK / (G * NWAVES); final_norm_rows(PP->out, PP->fing, (vcu * NWAVES + wave) * rpw, rpw, lane); }
}

extern "C" void kernel_launch(void* const* d_in, const int* in_sizes, int n_in, void* d_out, int out_size, void* d_ws, size_t ws_size, hipStream_t stream) {
    static int grid = 0;
    if (grid == 0) {
        if (n_in != 14 || in_sizes[0] != MTOK * DM || out_size != MTOK * DM || ws_size < WS_END) { fprintf(stderr, "kernel_launch: unexpected shapes (n_in %d, in0 %d, out %d, ws %zu < %zu); nothing launched\n", n_in, n_in > 0 ? in_sizes[0] : -1, out_size, ws_size, (size_t)WS_END); grid = -1; return; }
        int dev = 0, cus = 0, per_cu = 0;
        if (hipGetDevice(&dev) != hipSuccess || hipDeviceGetAttribute(&cus, hipDeviceAttributeMultiprocessorCount, dev) != hipSuccess) { grid = -1; return; }
        if (hipFuncSetAttribute((const void*)mega_fwd, hipFuncAttributeMaxDynamicSharedMemorySize, LDS_BYTES) != hipSuccess) { fprintf(stderr, "kernel_launch: hipFuncSetAttribute failed\n"); grid = -1; return; }
        if (hipOccupancyMaxActiveBlocksPerMultiprocessor(&per_cu, (const void*)mega_fwd, NWAVES * 64, LDS_BYTES) != hipSuccess || per_cu < 1) { fprintf(stderr, "kernel_launch: occupancy query gave %d\n", per_cu); per_cu = 1; }
        (void)hipGetLastError();
        grid = cus * per_cu;
        if (CH % (grid * NWAVES) != 0 || grid % 8 != 0) { fprintf(stderr, "kernel_launch: grid %d does not divide the row split\n", grid); grid = -1; return; }
    }
    if (grid < 0) return;
    Params p{};
    p.x = (const float*)d_in[0]; p.c = (const float*)d_in[1]; p.fng = (const float*)d_in[2]; p.fwada = (const float*)d_in[3]; p.fbada = (const float*)d_in[4];
    p.fwin = (const float*)d_in[5]; p.fbf = (const float*)d_in[6]; p.fwout = (const float*)d_in[7]; p.sng = (const float*)d_in[8]; p.swada = (const float*)d_in[9];
    p.sbada = (const float*)d_in[10]; p.swin = (const float*)d_in[11]; p.swout = (const float*)d_in[12]; p.fing = (const float*)d_in[13];
    p.out = (float*)d_out; p.ws = (unsigned char*)d_ws;
    void* args[] = {&p};
    hipError_t e = hipLaunchCooperativeKernel((const void*)mega_fwd, dim3(grid), dim3(NWAVES * 64), args, LDS_BYTES, stream);
    if (e != hipSuccess) fprintf(stderr, "kernel_launch: cooperative launch failed: %s (grid %d)\n", hipGetErrorString(e), grid);
}
```

```cpp
#include <hip/hip_runtime.h>
#include <hip/hip_cooperative_groups.h>
#include <hip/hip_bf16.h>
#include <cstdio>
#include <cstdint>
#include <cmath>
#include <type_traits>
namespace cg = cooperative_groups;
namespace pg8 {
#define PG8_LAS __attribute__((address_space(3)))
typedef unsigned short bf16_t;
typedef short bf16x8 __attribute__((ext_vector_type(8)));
typedef float f32x4 __attribute__((ext_vector_type(4)));
typedef unsigned u32x4 __attribute__((ext_vector_type(4)));
constexpr int BM = 256, BK = 64, HALF = 128, HTB = HALF * BK * 2  , STAGE_BYTES = 8 * HTB, NXCD = 8, WGM = 8;

__host__ __device__ __forceinline__ int lds_byte(int r, int c) { const int st = (r >> 4) * 2 + (c >> 5), rr = r & 15, cc = c & 31, ob = rr * 64 + cc * 2; return st * 1024 + (ob ^ (((ob >> 9) & 1) << 5)); }
__host__ __device__ __forceinline__ void stage_rc(int b, int& R, int& C) { const int st = b / 1024, sb = b % 1024, swz = sb ^ (((sb >> 9) & 1) << 5); R = (st >> 1) * 16 + swz / 64; C = (st & 1) * 32 + (swz % 64) / 2; }
__host__ __device__ __forceinline__ int perm32(int rho) { const int n = rho >> 4, i = rho & 15; return 8 * (i >> 2) + 4 * n + (i & 3); }

struct Unit { int pm, pn; };
struct Gemm { const bf16_t* A; const bf16_t* Bt; int M, N, K; };

struct StaticOrder {
    int nM, nN, nwg, G, c;
    __host__ __device__ void init(int M, int N, int G_, int c_) { nM = M / BM; nN = N / BM; nwg = nM * nN; G = G_; c = c_; }
    __host__ __device__ bool next(int i, Unit& u) const {
        const long L = (long)i * G + c; if (L >= nwg) return false;
        int wgid = (int)L; { const int q = nwg / NXCD, r = nwg % NXCD, xcd = wgid % NXCD, off = wgid / NXCD; wgid = (xcd < r ? xcd * (q + 1) : r * (q + 1) + (xcd - r) * q) + off; }
        const int nig = WGM * nN, gid = wgid / nig, fm = gid * WGM, gsz = (nM - fm) < WGM ? (nM - fm) : WGM;
        u.pm = fm + ((wgid % nig) % gsz); u.pn = (wgid % nig) / gsz; return true;
    }
    __device__ __forceinline__ void a_ready(const Unit&) const {}
    __device__ __forceinline__ void done(const Unit&) const {}
};

__device__ __forceinline__ unsigned cvt_pk_bf16(float lo, float hi) { unsigned r; asm volatile("v_cvt_pk_bf16_f32 %0, %1, %2" : "=v"(r) : "v"(lo), "v"(hi)); return r; }
typedef float f32x2 __attribute__((ext_vector_type(2)));
typedef float f32x2 __attribute__((ext_vector_type(2)));
struct EpiProj {
    static constexpr bool PERM = true, AFTER_DRAIN = false;
    bf16_t* O; size_t split_stride; float scale0; float* lf; const float* bf;
    __device__ __forceinline__ void operator()(const f32x4 (&acc)[2][2][4][2], const Unit& u, int wr, int wc, int fr, int fq) const {
        const int t = u.pn >> 3;
        const int row0 = u.pm * BM + wr * 64 + fr;
        if (t < 4) {
            bf16_t* base = O + (size_t)t * split_stride; const float sc = (t == 0) ? scale0 : 1.f;
            const int col0 = (u.pn & 7) * BM + wc * 32 + 8 * fq;
#pragma unroll
            for (int ai = 0; ai < 2; ++ai)
#pragma unroll
                for (int m = 0; m < 4; ++m) { bf16_t* rowp = base + (size_t)(row0 + ai * HALF + m * 16) * 2048 + col0;
#pragma unroll
                    for (int bj = 0; bj < 2; ++bj) { f32x4 v0 = acc[ai][bj][m][0] * sc, v1 = acc[ai][bj][m][1] * sc;
                        u32x4 w; w.x = cvt_pk_bf16(v0[0], v0[1]); w.y = cvt_pk_bf16(v0[2], v0[3]); w.z = cvt_pk_bf16(v1[0], v1[1]); w.w = cvt_pk_bf16(v1[2], v1[3]);
                        *(u32x4*)(rowp + bj * HALF) = w; } }
        } else if (wc == 0) {
            f32x4 bv[2];
#pragma unroll
            for (int n = 0; n < 2; ++n) bv[n] = *(const f32x4*)(bf + 8 * fq + 4 * n);
#pragma unroll
            for (int ai = 0; ai < 2; ++ai)
#pragma unroll
                for (int m = 0; m < 4; ++m) { float* rowp = lf + (size_t)(row0 + ai * HALF + m * 16) * 32 + 8 * fq;
#pragma unroll
                    for (int n = 0; n < 2; ++n) { f32x4 v = acc[ai][0][m][n] + bv[n]; f32x4 o;
#pragma unroll
                        for (int e = 0; e < 4; ++e) { const float xx = v[e]; o[e] = (fminf(xx, 0.f) - log1pf(__expf(-fabsf(xx)))) * 1.4426950408889634f; }
                        *(f32x4*)(rowp + 4 * n) = o; } }
        }
    }
};
struct EpiRes {
    static constexpr bool PERM = false, AFTER_DRAIN = false;
    const float* base; float* out; const float* gate; int row_off;
    __device__ __forceinline__ void operator()(const f32x4 (&acc)[2][2][4][2], const Unit& u, int wr, int wc, int fr, int fq) const {
        const int col0 = u.pn * BM + wc * 32 + 4 * fq; const int b = (row_off + u.pm * BM) >> 11;
        f32x4 gv[2][2];
#pragma unroll
        for (int bj = 0; bj < 2; ++bj)
#pragma unroll
            for (int n = 0; n < 2; ++n) gv[bj][n] = *(const f32x4*)(gate + (size_t)b * 3072 + col0 + bj * HALF + n * 16);
#pragma unroll
        for (int ai = 0; ai < 2; ++ai)
#pragma unroll
            for (int m = 0; m < 4; ++m) { const size_t off = (size_t)(row_off + u.pm * BM + wr * 64 + fr + ai * HALF + m * 16) * 1024 + col0;
#pragma unroll
                for (int bj = 0; bj < 2; ++bj)
#pragma unroll
                    for (int n = 0; n < 2; ++n) { const f32x4 bs = *(const f32x4*)(base + off + bj * HALF + n * 16);
                        *(f32x4*)(out + off + bj * HALF + n * 16) = bs + gv[bj][n] * acc[ai][bj][m][n]; } }
    }
};
template <class Epi, class Sched, bool ALIGN_EPI = false, bool SP2 = false>
__device__ __forceinline__ void gemm_phase(PG8_LAS unsigned char* lds, const Gemm g, const Sched& S, const Epi& E) {
    int tid_ = threadIdx.x; asm volatile("" : "+v"(tid_));
    const int tid = tid_, wid = __builtin_amdgcn_readfirstlane(tid >> 6), lane = tid & 63, wr = wid >> 2, wc = wid & 3, fr = lane & 15, fq = lane >> 4;
    const int K = g.K, nt = K / BK;
    unsigned voffA[2], voffB[2];
#pragma unroll
    for (int i = 0; i < 2; ++i) { int R, C; stage_rc(tid * 16 + i * 8192, R, C); const int Rb = Epi::PERM ? ((R & ~31) + perm32(R & 31)) : R;
        voffA[i] = (unsigned)(R * K + C) * 2u; voffB[i] = (unsigned)(Rb * K + C) * 2u; }
    const size_t kstep = (size_t)(BK * 2);
    const size_t hstep = (size_t)HALF * K * 2;
    const size_t tstep = 2 * hstep;
    const unsigned ldsw = (unsigned)wid * 1024u;
    const int aoff = lds_byte(wr * 64 + fr, fq * 8), boff = lds_byte(wc * 32 + fr, fq * 8);
#define PG8_SA(b, h) (((b) * 2 + (h)) * HTB)
#define PG8_SB(b, h) ((4 + (b) * 2 + (h)) * HTB)
#define PG8_STAGE(bufoff, gbase, voff) do { _Pragma("unroll") for (int _i = 0; _i < 2; ++_i) \
        __builtin_amdgcn_global_load_lds((const unsigned*)((const char*)(gbase) + (voff)[_i]), (PG8_LAS unsigned*)(lds + (bufoff) + ldsw + _i * 8192), 16, 0, 0); } while (0)
#define PG8_LDA(dst, b, h) do { _Pragma("unroll") for (int m = 0; m < 4; ++m) _Pragma("unroll") for (int k = 0; k < 2; ++k) dst[m][k] = *(const PG8_LAS bf16x8*)(lds + PG8_SA(b, h) + aoff + m * 2048 + k * 1024); } while (0)
#define PG8_LDB(dst, b, h) do { _Pragma("unroll") for (int n = 0; n < 2; ++n) _Pragma("unroll") for (int k = 0; k < 2; ++k) dst[n][k] = *(const PG8_LAS bf16x8*)(lds + PG8_SB(b, h) + boff + n * 2048 + k * 1024); } while (0)
#define PG8_MMA(ai, bj, At, Bt) do { __builtin_amdgcn_s_setprio(1); _Pragma("unroll") for (int m = 0; m < 4; ++m) _Pragma("unroll") for (int n = 0; n < 2; ++n) _Pragma("unroll") for (int k = 0; k < 2; ++k) \
        acc[ai][bj][m][n] = __builtin_amdgcn_mfma_f32_16x16x32_bf16(Bt[n][k], At[m][k], acc[ai][bj][m][n], 0, 0, 0); __builtin_amdgcn_s_setprio(0); } while (0)
#define PG8_WAIT_V(n) asm volatile("s_waitcnt vmcnt(" #n ")" ::: "memory")
#define PG8_WAIT_L(n) asm volatile("s_waitcnt lgkmcnt(" #n ")" ::: "memory")
#define PG8_BAR __builtin_amdgcn_s_barrier()
#define PG8_SCHED __builtin_amdgcn_sched_barrier(0)
    Unit cur, nxt; int ui = 0;
    if (!S.next(0, cur)) return;
    f32x4 acc[2][2][4][2];
#pragma unroll
    for (int a = 0; a < 2; ++a)
#pragma unroll
        for (int b = 0; b < 2; ++b)
#pragma unroll
            for (int m = 0; m < 4; ++m)
#pragma unroll
                for (int n = 0; n < 2; ++n) acc[a][b][m][n] = (f32x4){0.f, 0.f, 0.f, 0.f};
    bf16x8 At[4][2], B0[2][2], B1[2][2];
    const char* cA = (const char*)g.A + (size_t)cur.pm * tstep; const char* cB = (const char*)g.Bt + (size_t)cur.pn * tstep;
    S.a_ready(cur);
    if constexpr (SP2) {
        PG8_STAGE(PG8_SB(0, 0), cB, voffB); PG8_STAGE(PG8_SB(0, 1), cB + hstep, voffB); PG8_STAGE(PG8_SA(0, 0), cA, voffA); PG8_STAGE(PG8_SA(0, 1), cA + hstep, voffA);
        if (wr == 1) PG8_BAR;
        PG8_WAIT_V(2); PG8_BAR;
        PG8_STAGE(PG8_SB(1, 0), cB + kstep, voffB); PG8_STAGE(PG8_SA(1, 0), cA + kstep, voffA); PG8_STAGE(PG8_SB(1, 1), cB + hstep + kstep, voffB);
        PG8_WAIT_V(6); PG8_BAR;
    } else {
        PG8_STAGE(PG8_SB(0, 0), cB, voffB); PG8_STAGE(PG8_SA(0, 0), cA, voffA); PG8_STAGE(PG8_SB(0, 1), cB + hstep, voffB); PG8_STAGE(PG8_SA(0, 1), cA + hstep, voffA);
        if (wr == 1) PG8_BAR;
        PG8_WAIT_V(4); PG8_BAR;
        PG8_STAGE(PG8_SB(1, 0), cB + kstep, voffB); PG8_STAGE(PG8_SA(1, 0), cA + kstep, voffA); PG8_STAGE(PG8_SB(1, 1), cB + hstep + kstep, voffB);
        PG8_WAIT_V(6); PG8_BAR;
    }
    for (;;) {
        const bool has_next = S.next(ui + 1, nxt);
        const char* nA = has_next ? (const char*)g.A + (size_t)nxt.pm * tstep : cA; const char* nB = has_next ? (const char*)g.Bt + (size_t)nxt.pn * tstep : cB;
        for (int t = 0; t < nt; t += 2) {
            const bool last = (t == nt - 2);
            const char* a1 = cA + (size_t)(t + 1) * kstep;
            const char* a2 = last ? nA : cA + (size_t)(t + 2) * kstep; const char* b2 = last ? nB : cB + (size_t)(t + 2) * kstep;
            const char* a3 = a2 + kstep; const char* b3 = b2 + kstep;
            if (last && has_next) S.a_ready(nxt);
            if constexpr (SP2) {
            PG8_LDB(B0, 0, 0); PG8_LDB(B1, 0, 1); PG8_SCHED; PG8_LDA(At, 0, 0); PG8_STAGE(PG8_SA(1, 1), a1 + hstep, voffA);
            PG8_WAIT_V(8); PG8_WAIT_L(0); PG8_BAR; PG8_MMA(0, 0, At, B0); PG8_MMA(0, 1, At, B1); PG8_BAR; PG8_SCHED;
            PG8_LDA(At, 0, 1); PG8_STAGE(PG8_SB(0, 0), b2, voffB); PG8_STAGE(PG8_SB(0, 1), b2 + hstep, voffB); PG8_STAGE(PG8_SA(0, 0), a2, voffA);
            PG8_WAIT_V(8); PG8_WAIT_L(0); PG8_BAR; PG8_MMA(1, 0, At, B0); PG8_MMA(1, 1, At, B1); PG8_BAR; PG8_SCHED;
            PG8_LDB(B0, 1, 0); PG8_LDB(B1, 1, 1); PG8_SCHED; PG8_LDA(At, 1, 0); PG8_STAGE(PG8_SA(0, 1), a2 + hstep, voffA);
            PG8_WAIT_V(8); PG8_WAIT_L(0); PG8_BAR; PG8_MMA(0, 0, At, B0); PG8_MMA(0, 1, At, B1); PG8_BAR; PG8_SCHED;
            PG8_LDA(At, 1, 1); PG8_STAGE(PG8_SB(1, 0), b3, voffB); PG8_STAGE(PG8_SB(1, 1), b3 + hstep, voffB); PG8_STAGE(PG8_SA(1, 0), a3, voffA);
            PG8_WAIT_V(8); PG8_WAIT_L(0); PG8_BAR; PG8_MMA(1, 0, At, B0); PG8_MMA(1, 1, At, B1); PG8_BAR; PG8_SCHED;
            } else {
            PG8_LDB(B0, 0, 0); PG8_SCHED; PG8_LDA(At, 0, 0); PG8_STAGE(PG8_SA(1, 1), a1 + hstep, voffA);
            PG8_WAIT_L(8); PG8_BAR; PG8_WAIT_L(0); PG8_MMA(0, 0, At, B0); PG8_BAR; PG8_SCHED;
            PG8_LDB(B1, 0, 1); PG8_STAGE(PG8_SB(0, 0), b2, voffB);
            PG8_BAR; PG8_WAIT_L(0); PG8_MMA(0, 1, At, B1); PG8_BAR;
            PG8_LDA(At, 0, 1); PG8_STAGE(PG8_SA(0, 0), a2, voffA);
            PG8_BAR; PG8_WAIT_L(0); PG8_MMA(1, 0, At, B0); PG8_BAR; PG8_SCHED;
            PG8_STAGE(PG8_SB(0, 1), b2 + hstep, voffB);
            PG8_WAIT_V(6); PG8_BAR; PG8_MMA(1, 1, At, B1); PG8_BAR;
            PG8_LDB(B0, 1, 0); PG8_SCHED; PG8_LDA(At, 1, 0); PG8_STAGE(PG8_SA(0, 1), a2 + hstep, voffA);
            PG8_WAIT_L(8); PG8_BAR; PG8_WAIT_L(0); PG8_MMA(0, 0, At, B0); PG8_BAR; PG8_SCHED;
            PG8_LDB(B1, 1, 1); PG8_STAGE(PG8_SB(1, 0), b3, voffB);
            PG8_BAR; PG8_WAIT_L(0); PG8_MMA(0, 1, At, B1); PG8_BAR;
            PG8_LDA(At, 1, 1); PG8_STAGE(PG8_SA(1, 0), a3, voffA);
            PG8_BAR; PG8_WAIT_L(0); PG8_MMA(1, 0, At, B0); PG8_BAR; PG8_SCHED;
            PG8_STAGE(PG8_SB(1, 1), b3 + hstep, voffB);
            PG8_WAIT_V(6); PG8_BAR; PG8_MMA(1, 1, At, B1); PG8_BAR;
            }
        }
        if constexpr (ALIGN_EPI) { if (wr == 0) PG8_BAR; }
        if constexpr (!Epi::AFTER_DRAIN) { E(acc, cur, wr, wc, fr, fq); S.done(cur); }
        if (!has_next) break;
#pragma unroll
        for (int a = 0; a < 2; ++a)
#pragma unroll
            for (int b = 0; b < 2; ++b)
#pragma unroll
                for (int m = 0; m < 4; ++m)
#pragma unroll
                    for (int n = 0; n < 2; ++n) acc[a][b][m][n] = (f32x4){0.f, 0.f, 0.f, 0.f};
        cur = nxt; cA = nA; cB = nB; ++ui;
        if constexpr (ALIGN_EPI) { if (wr == 1) PG8_BAR; }
    }
    PG8_WAIT_V(0);
    if constexpr (!ALIGN_EPI) { if (wr == 0) PG8_BAR; }
    PG8_BAR;
    if constexpr (Epi::AFTER_DRAIN) { E.fused(acc, cur, wr, wc, fr, fq, lds, wid, lane); S.done(cur); }
#undef PG8_SA
#undef PG8_SB
#undef PG8_STAGE
#undef PG8_LDA
#undef PG8_LDB
#undef PG8_MMA
#undef PG8_WAIT_V
#undef PG8_WAIT_L
#undef PG8_BAR
#undef PG8_SCHED
}
}
namespace att {
typedef __hip_bfloat16 bf16;
typedef __attribute__((ext_vector_type(8))) short bf16x8;
typedef __attribute__((ext_vector_type(4))) short s16x4;
typedef __attribute__((ext_vector_type(16))) float f32x16;
typedef __attribute__((ext_vector_type(4))) float f32x4;
typedef __attribute__((ext_vector_type(4))) unsigned u32x4;
typedef __attribute__((ext_vector_type(2))) unsigned u32x2;
#define ALAS __attribute__((address_space(3)))
constexpr int PITCH = 2048, SEQ = 2048, D = 64, QB = 256, KVB = 64, NQB = SEQ / QB;
constexpr int SLOTB = 16384, NSLOT = 6;
constexpr int L_CUM = NSLOT * SLOTB, L_WSF = L_CUM + SEQ * 4, L_MISC = L_WSF + 8 * 256, L_END = L_MISC + 256;
constexpr float C2 = 0.125f * 1.4426950408889634f;
__device__ __forceinline__ int crow(int r, int hi) { return (r & 3) + 8 * (r >> 2) + 4 * hi; }
__device__ __forceinline__ void glds16(const void* gsrc, unsigned lds_dst) { unsigned keep;
  asm volatile("s_mov_b32 %0, m0\n\ts_mov_b32 m0, %2\n\ts_nop 0\n\tglobal_load_lds_dwordx4 %1, off\n\ts_mov_b32 m0, %0" : "=&s"(keep) : "v"(gsrc), "s"(lds_dst) : "memory"); }
typedef float f32x2_t __attribute__((ext_vector_type(2))); typedef __bf16 bf16x2_t __attribute__((ext_vector_type(2)));
__device__ __forceinline__ unsigned cvtpk(float lo, float hi) { f32x2_t v = {lo, hi}; bf16x2_t b = __builtin_convertvector(v, bf16x2_t); return __builtin_bit_cast(unsigned, b); }
typedef short v4i16_t __attribute__((ext_vector_type(4)));
__device__ __forceinline__ s16x4 vtr(const ALAS char* p) { return __builtin_bit_cast(s16x4, __builtin_amdgcn_ds_read_tr16_b64_v4i16((ALAS v4i16_t*)p)); }
__device__ __forceinline__ float swap_sum(float v) { auto rr = __builtin_amdgcn_permlane32_swap(__float_as_uint(v), __float_as_uint(v), false, false); return __uint_as_float(rr[0]) + __uint_as_float(rr[1]); }
__device__ __forceinline__ float swap_max(float v) { auto rr = __builtin_amdgcn_permlane32_swap(__float_as_uint(v), __float_as_uint(v), false, false); return fmaxf(__uint_as_float(rr[0]), __uint_as_float(rr[1])); }
#define AWAIT_BAR(N) asm volatile("s_waitcnt vmcnt(" #N ") lgkmcnt(0)\n\ts_barrier" ::: "memory")

struct St { f32x16 o0, o1; float mhat, l, R; };

__device__ __forceinline__ void qkt(f32x16& p0, f32x16& p1, const ALAS char* kp, const bf16x8* qr, const f32x16& c0, const f32x16& c1) {
#pragma unroll
  for (int d0 = 0; d0 < 4; ++d0) {
    const bf16x8 b0 = *(const ALAS bf16x8*)(kp + d0 * 2048);
    const bf16x8 b1 = *(const ALAS bf16x8*)(kp + d0 * 2048 + 512);
    if (d0 == 0) { p0 = __builtin_amdgcn_mfma_f32_32x32x16_bf16(b0, qr[0], c0, 0, 0, 0); p1 = __builtin_amdgcn_mfma_f32_32x32x16_bf16(b1, qr[0], c1, 0, 0, 0); }
    else { p0 = __builtin_amdgcn_mfma_f32_32x32x16_bf16(b0, qr[d0], p0, 0, 0, 0); p1 = __builtin_amdgcn_mfma_f32_32x32x16_bf16(b1, qr[d0], p1, 0, 0, 0); }
  }
}
__device__ __forceinline__ void pv(St& s, const ALAS char* vp, const f32x16& p0, const f32x16& p1) {
  u32x4 pw[4];
  pw[0] = (u32x4){cvtpk(p0[0], p0[1]), cvtpk(p0[2], p0[3]), cvtpk(p0[4], p0[5]), cvtpk(p0[6], p0[7])};
  pw[1] = (u32x4){cvtpk(p0[8], p0[9]), cvtpk(p0[10], p0[11]), cvtpk(p0[12], p0[13]), cvtpk(p0[14], p0[15])};
  pw[2] = (u32x4){cvtpk(p1[0], p1[1]), cvtpk(p1[2], p1[3]), cvtpk(p1[4], p1[5]), cvtpk(p1[6], p1[7])};
  pw[3] = (u32x4){cvtpk(p1[8], p1[9]), cvtpk(p1[10], p1[11]), cvtpk(p1[12], p1[13]), cvtpk(p1[14], p1[15])};
#pragma unroll
  for (int ks = 0; ks < 4; ++ks) {
    const s16x4 a0 = vtr(vp + ks * 1024), a1 = vtr(vp + ks * 1024 + 512), b0 = vtr(vp + 4096 + ks * 1024), b1 = vtr(vp + 4096 + ks * 1024 + 512);
    const bf16x8 v0 = (bf16x8){a0[0], a0[1], a0[2], a0[3], a1[0], a1[1], a1[2], a1[3]};
    const bf16x8 v1 = (bf16x8){b0[0], b0[1], b0[2], b0[3], b1[0], b1[1], b1[2], b1[3]};
    s.o0 = __builtin_amdgcn_mfma_f32_32x32x16_bf16(__builtin_bit_cast(bf16x8, pw[ks]), v0, s.o0, 0, 0, 0);
    s.o1 = __builtin_amdgcn_mfma_f32_32x32x16_bf16(__builtin_bit_cast(bf16x8, pw[ks]), v1, s.o1, 0, 0, 0);
  }
}

template <bool DIAG, bool FIRST>
__device__ __forceinline__ void fox_tile(St& s, const ALAS char* kp, const ALAS char* vp, const bf16x8* qr, const ALAS float* ck, float cq2, int jb, int qrel, int hi, int r32, ALAS float* wsf) {
  f32x16 c0, c1; const float cb = cq2 - s.mhat;
#pragma unroll
  for (int g = 0; g < 4; ++g) { const f32x4 a = *(const ALAS f32x4*)(ck + 8 * g + 4 * hi), b = *(const ALAS f32x4*)(ck + 32 + 8 * g + 4 * hi);
#pragma unroll
    for (int i = 0; i < 4; ++i) { c0[4 * g + i] = cb - a[i]; c1[4 * g + i] = cb - b[i]; } }
  f32x16 p0, p1; qkt(p0, p1, kp, qr, c0, c1);
  if (DIAG) {
    const float U = ((float)(qrel - 64 * jb - 4 * hi) + 0.5f) * 0x1p100f;
#pragma unroll
    for (int r = 0; r < 16; ++r) { const float c = (float)((r & 3) + 8 * (r >> 2)); p0[r] = fminf(p0[r], U - c * 0x1p100f); p1[r] = fminf(p1[r], U - (c + 32.0f) * 0x1p100f); }
  }
  float a = fmaxf(p0[0], p1[0]);
#pragma unroll
  for (int r = 1; r < 16; ++r) a = fmaxf(a, fmaxf(p0[r], p1[r]));
  const float rm = swap_max(a);
  if (FIRST) {
    s.mhat += rm;
#pragma unroll
    for (int r = 0; r < 16; ++r) { p0[r] -= rm; p1[r] -= rm; }
  } else if (__any(rm > 8.0f)) {
    const float dl = fmaxf(rm, 0.f); s.mhat += dl;
#pragma unroll
    for (int r = 0; r < 16; ++r) { p0[r] -= dl; p1[r] -= dl; }
    const float f = __builtin_amdgcn_exp2f(-dl); s.l *= f;
    if (hi == 0) wsf[r32] = f;
    asm volatile("s_waitcnt lgkmcnt(0)" ::: "memory");
#pragma unroll
    for (int r = 0; r < 16; ++r) { const float fr_ = wsf[crow(r, hi)]; s.o0[r] *= fr_; s.o1[r] *= fr_; }
    asm volatile("s_waitcnt lgkmcnt(0)" ::: "memory");
  }
  float sum = 0.f;
#pragma unroll
  for (int r = 0; r < 16; ++r) { p0[r] = __builtin_amdgcn_exp2f(p0[r]); p1[r] = __builtin_amdgcn_exp2f(p1[r]); sum += p0[r] + p1[r]; }
  s.l += sum;
  pv(s, vp, p0, p1);
}

template <bool DIAG>
__device__ __forceinline__ void sb_tile(St& s, const ALAS char* kp, const ALAS char* vp, const bf16x8* qr, int jb, int qrel, int hi) {
  f32x16 p0, p1; const f32x16 z = {};
  qkt(p0, p1, kp, qr, z, z);
  if (DIAG) {
    const float U = ((float)(qrel - 64 * jb - 4 * hi) - 0.5f) * 0x1p100f;
#pragma unroll
    for (int r = 0; r < 16; ++r) { const float c = (float)((r & 3) + 8 * (r >> 2)); p0[r] = fminf(p0[r], U - c * 0x1p100f); p1[r] = fminf(p1[r], U - (c + 32.0f) * 0x1p100f); }
  }
#pragma unroll
  for (int r = 0; r < 16; ++r) {
    const float e0 = __builtin_amdgcn_exp2f(fminf(p0[r], 126.f)), e1 = __builtin_amdgcn_exp2f(fminf(p1[r], 126.f));
    p0[r] = __builtin_amdgcn_rcpf(1.0f + e0); p1[r] = __builtin_amdgcn_rcpf(1.0f + e1);
  }
  float Y = s.R;
#pragma unroll
  for (int j = 0; j < 8; ++j) {
    const int g = (j < 4) ? (3 - j) : (7 - j);
    f32x16& P = (j < 4) ? p1 : p0;
    const float k0 = P[4 * g], k1 = P[4 * g + 1], k2 = P[4 * g + 2], k3 = P[4 * g + 3];
    const float t1 = k3 * k2, t0 = t1 * k1, G = t0 * k0;
    auto rr = __builtin_amdgcn_permlane32_swap(__float_as_uint(G), __float_as_uint(G), false, false);
    const float Go = __uint_as_float(rr[0]), Ge = __uint_as_float(rr[1]);
    const float Y1 = Y * Ge, Y2 = Y1 * Go;
    const float X = hi ? Y : Y1, XG = hi ? Y1 : Y2;
    const float pe2 = X * k3, pe1 = X * t1, pe0 = X * t0;
    P[4 * g + 3] = X - pe2; P[4 * g + 2] = pe2 - pe1; P[4 * g + 1] = pe1 - pe0; P[4 * g] = pe0 - XG;
    Y = Y2;
  }
  s.R = Y;
  pv(s, vp, p0, p1);
}

template <int MODE>
__device__ __forceinline__ void unit(int tok0, int h, int qb, const bf16* Q, const bf16* K, const bf16* V, const bf16* Z, bf16* O, ALAS char* shm3) {
  int tid_ = threadIdx.x; asm volatile("" : "+v"(tid_));
  const int tid = tid_, lane = tid & 63, r32 = lane & 31, hi = lane >> 5; const int wid = __builtin_amdgcn_readfirstlane(tid >> 6);
  const int q0 = qb * QB, pr = wid >> 1, w2 = wid & 1;
  const bf16* Qw = Q + (size_t)(tok0 + q0 + wid * 32) * PITCH + h * D;
  const bf16* Kh = K + (size_t)tok0 * PITCH + h * D; const bf16* Vh = V + (size_t)tok0 * PITCH + h * D;
  const unsigned lds0 = (unsigned)(uintptr_t)shm3;
  ALAS float* wsf = (ALAS float*)(shm3 + L_WSF) + wid * 64;
  const ALAS float* cum = (const ALAS float*)(shm3 + L_CUM);
  ALAS unsigned* misc = (ALAS unsigned*)(shm3 + L_MISC);
  const bf16* ksrc = Kh + (size_t)lane * PITCH + wid * 8;
  const bf16* vsrc = Vh + (size_t)(16 * (wid & 3) + (lane >> 2)) * PITCH + (wid >> 2) * 32 + (lane & 3) * 8;
  const unsigned kdst = lds0 + wid * 1024, vdst = lds0 + 8192 + wid * 1024;
#define DMA_KV(jt) do { const int sl_ = (jt) % NSLOT; glds16(ksrc + (size_t)(jt) * KVB * PITCH, (unsigned)__builtin_amdgcn_readfirstlane(kdst + sl_ * SLOTB)); \
                        glds16(vsrc + (size_t)(jt) * KVB * PITCH, (unsigned)__builtin_amdgcn_readfirstlane(vdst + sl_ * SLOTB)); } while (0)
  const int jb0 = 4 * qb;
  DMA_KV(jb0 + 3); DMA_KV(jb0 + 2); DMA_KV(jb0 + 1); DMA_KV(jb0);
  bf16x8 qr[4];
#pragma unroll
  for (int d0 = 0; d0 < 4; ++d0) qr[d0] = *(const bf16x8*)(Qw + (size_t)r32 * PITCH + d0 * 16 + hi * 8);
  if (jb0 > 0) DMA_KV(jb0 - 1);
  St s; s.o0 = f32x16{}; s.o1 = f32x16{}; s.mhat = 0.f; s.l = 0.f; s.R = 1.0f;
  const int qrel = w2 * 32 + r32; const int jd = jb0 + pr;
  float cq2 = 0.f, qkb = 0.f;
  if (MODE == 0) {
    cq2 = cum[q0 + wid * 32 + r32];
    float n2 = 0.f;
#pragma unroll
    for (int d0 = 0; d0 < 4; ++d0)
#pragma unroll
      for (int e = 0; e < 8; ++e) { const float v = __uint_as_float(((unsigned)(unsigned short)qr[d0][e]) << 16); n2 += v * v; }
    qkb = sqrtf(swap_sum(n2)) * __uint_as_float(misc[1]) * 1.0001f;
  }
  const ALAS char* kp0 = shm3 + hi * 1024 + r32 * 16;
  const ALAS char* vp0 = shm3 + 8192 + ((lane >> 4) & 1) * 32 + (lane & 3) * 8 + (4 * hi + ((lane & 15) >> 2)) * 64;
  if (jb0 > 0) AWAIT_BAR(2); else AWAIT_BAR(0);
  bool done = false;
  const int NSTEP = jb0 + 4;
  for (int i = 0; i < NSTEP; ++i) {
    const int jt = jd - i, pre = jb0 - i - 2;
    if (pre >= 0) DMA_KV(pre);
    if (!done) {
      if (jt < 0) done = true;
      else {
        const int sl = jt % NSLOT;
        const ALAS char* kp = kp0 + sl * SLOTB; const ALAS char* vp = vp0 + sl * SLOTB;
        if (MODE == 0) {
          if (i == 0) fox_tile<true, true>(s, kp, vp, qr, cum + 64 * jt, cq2, 0, qrel, hi, r32, wsf);
          else fox_tile<false, false>(s, kp, vp, qr, cum + 64 * jt, cq2, 0, qrel, hi, r32, wsf);
          if (jt == 0) done = true;
          else { const float cprev = cum[64 * jt - 1]; done = __all((11.0f + qkb + cq2 - cprev - s.mhat) < -40.0f) != 0; }
        } else {
          if (i == 0) sb_tile<true>(s, kp, vp, qr, 0, qrel, hi);
          else sb_tile<false>(s, kp, vp, qr, 0, qrel, hi);
          if (jt == 0) done = true;
          else done = __all(s.R < 0x1p-60f) != 0;
        }
      }
    }
    if (lane == 0) misc[8 + 8 * (i & 1) + wid] = done ? 1u : 0u;
    if (pre >= 0) AWAIT_BAR(2); else AWAIT_BAR(0);
    const u32x4 f0 = *(const ALAS u32x4*)(misc + 8 + 8 * (i & 1)), f1 = *(const ALAS u32x4*)(misc + 12 + 8 * (i & 1));
    const unsigned alld = (f0[0] & f0[1] & f0[2] & f0[3]) & (f1[0] & f1[1] & f1[2] & f1[3]);
    if (__builtin_amdgcn_readfirstlane(alld)) break;
  }
#undef DMA_KV
  AWAIT_BAR(0);
  if (MODE == 0) {
    const float lt = swap_sum(s.l); const float inv = __builtin_amdgcn_rcpf(lt);
    if (hi == 0) wsf[r32] = inv;
    asm volatile("s_waitcnt lgkmcnt(0)" ::: "memory");
#pragma unroll
    for (int r = 0; r < 16; ++r) { const float f = wsf[crow(r, hi)]; s.o0[r] *= f; s.o1[r] *= f; }
  }
  ALAS float* stg = (ALAS float*)(shm3 + wid * 8192);
#pragma unroll
  for (int r = 0; r < 16; ++r) { const int orow = crow(r, hi); stg[orow * 64 + r32] = s.o0[r]; stg[orow * 64 + 32 + r32] = s.o1[r]; }
  asm volatile("s_waitcnt lgkmcnt(0)" ::: "memory");
  const bf16* Zw = Z + (size_t)(tok0 + q0 + wid * 32) * PITCH + h * D;
  bf16* Ow = O + (size_t)(tok0 + q0 + wid * 32) * PITCH + h * D;
#pragma unroll
  for (int i = 0; i < 4; ++i) {
    const int row = i * 8 + (lane >> 3), ch = lane & 7;
    const u32x4 zz = *(const u32x4*)(Zw + (size_t)row * PITCH + ch * 8);
    const f32x4 a = *(const ALAS f32x4*)(stg + row * 64 + ch * 8), b = *(const ALAS f32x4*)(stg + row * 64 + ch * 8 + 4);
    float ov[8] = {a[0], a[1], a[2], a[3], b[0], b[1], b[2], b[3]};
    unsigned w[4];
#pragma unroll
    for (int e = 0; e < 4; ++e) {
      const float z0 = __uint_as_float(zz[e] << 16), z1 = __uint_as_float(zz[e] & 0xffff0000u);
      const float g0 = z0 * __builtin_amdgcn_rcpf(1.0f + __builtin_amdgcn_exp2f(-1.4426950408889634f * z0));
      const float g1 = z1 * __builtin_amdgcn_rcpf(1.0f + __builtin_amdgcn_exp2f(-1.4426950408889634f * z1));
      w[e] = cvtpk(ov[2 * e] * g0, ov[2 * e + 1] * g1);
    }
    *(u32x4*)(Ow + (size_t)row * PITCH + ch * 8) = (u32x4){w[0], w[1], w[2], w[3]};
  }
  AWAIT_BAR(0);
}
}
constexpr int NWAVES = 8;
constexpr int DM = 1024, NB = 32, SEQ = 2048, MTOK = NB * SEQ, DI = 2048, NH = 32;
constexpr int NCHUNK = 2, CH = MTOK / NCHUNK, CHB = NB / NCHUNK;
constexpr int NIN0 = 8448, NIN0_REAL = 8224, NIN1 = 8192;
constexpr float NORM_EPS = 1e-6f;
constexpr size_t MiB = 1u << 20;
constexpr size_t WS_WIN0 = 0, WS_WIN1 = 17 * MiB, WS_WOUT0 = 33 * MiB, WS_WOUT1 = 37 * MiB, WS_MOD = 41 * MiB, WS_LOGF = 42 * MiB, WS_H = 46 * MiB, WS_Q = 110 * MiB;
constexpr size_t WS_CNT = WS_MOD + 0xE0000;
constexpr size_t QKVZ_STRIDE = (size_t)CH * DI;
constexpr size_t WS_END = WS_Q + 4 * QKVZ_STRIDE * 2;
static_assert((size_t)NIN0 * DM * 2 <= WS_WIN1 && (size_t)CH * 32 * 4 <= WS_H - WS_LOGF && (size_t)CH * DM * 2 <= WS_Q - WS_H, "d_ws map");
constexpr int RING_BYTES = 131072, LDS_BYTES = 147456;
static_assert(att::L_END <= RING_BYTES, "attention LDS map");
#define GAS __attribute__((address_space(1)))
#define LAS __attribute__((address_space(3)))
typedef unsigned short bf16raw;
typedef unsigned v4u __attribute__((ext_vector_type(4)));
typedef float f32x4 __attribute__((ext_vector_type(4)));
#define LDS_WAIT() asm volatile("s_waitcnt lgkmcnt(0)" ::: "memory")
__device__ __forceinline__ unsigned f2bf(float f) { unsigned u = __builtin_bit_cast(unsigned, f); return (u + 0x7fffu + ((u >> 16) & 1u)) >> 16; }
__device__ __forceinline__ unsigned pk2(float lo, float hi) { return f2bf(lo) | (f2bf(hi) << 16); }
__device__ __forceinline__ float wave_sum(float v) {
#pragma unroll
    for (int o = 1; o < 64; o <<= 1) v += __shfl_xor(v, o);
    return v;
}
struct Params { const float *x, *c, *fng, *fwada, *fbada, *fwin, *fbf, *fwout, *sng, *swada, *sbada, *swin, *swout, *fing; float* out; unsigned char* ws; };

__device__ __forceinline__ void transpose_item(const float* W, int K, int N, bf16raw* WT, LAS float* scr, int item, int lane) {
    const int nblk = N / 32, kb = item / nblk, nb = item % nblk, k0 = 64 * kb, n0 = 32 * nb;
#pragma unroll 8
    for (int i = 0; i < 32; ++i) { const int kk = 2 * i + (lane >> 5); scr[kk * 33 + (lane & 31)] = W[(size_t)(k0 + kk) * N + n0 + (lane & 31)]; }
    LDS_WAIT(); asm volatile("" ::: "memory");
    const int c = lane & 7;
#pragma unroll
    for (int j = 0; j < 4; ++j) { const int n = (lane >> 3) + 8 * j; const LAS float* s = scr + (8 * c) * 33 + n;
        v4u o; o.x = pk2(s[0 * 33], s[1 * 33]); o.y = pk2(s[2 * 33], s[3 * 33]); o.z = pk2(s[4 * 33], s[5 * 33]); o.w = pk2(s[6 * 33], s[7 * 33]);
        *(v4u*)(WT + (size_t)(n0 + n) * K + k0 + 8 * c) = o; }
    LDS_WAIT(); asm volatile("" ::: "memory");
}

__device__ __forceinline__ void ada_item(const float* c, const float* W, const float* bias, float* mod, int cb, LAS unsigned char* lds, int tid) {
    const int lane = tid & 63, wave = tid >> 6;
    LAS float* sc = (LAS float*)lds + wave * 4096;
    for (int i = lane; i < 4096; i += 64) { const int b = i >> 7, kk = i & 127; const float v = c[b * DM + wave * 128 + kk]; sc[i] = v / (1.0f + __expf(-v)); }
    LDS_WAIT(); asm volatile("" ::: "memory");
    float acc[32];
#pragma unroll
    for (int b = 0; b < 32; ++b) acc[b] = 0.f;
    const float* Wp = W + (size_t)(wave * 128) * 3072 + cb * 64 + lane;
    for (int kk = 0; kk < 128; kk += 4) {
        const float w0 = Wp[(size_t)(kk + 0) * 3072], w1 = Wp[(size_t)(kk + 1) * 3072], w2 = Wp[(size_t)(kk + 2) * 3072], w3 = Wp[(size_t)(kk + 3) * 3072];
#pragma unroll
        for (int b = 0; b < 32; ++b) { const f32x4 s4 = *(const LAS f32x4*)(sc + b * 128 + kk); acc[b] += s4[0] * w0 + s4[1] * w1 + s4[2] * w2 + s4[3] * w3; }
    }
    __syncthreads();
    LAS float* red = (LAS float*)lds;
#pragma unroll
    for (int b = 0; b < 32; ++b) red[(wave * 32 + b) * 64 + lane] = acc[b];
    __syncthreads();
    for (int o = tid; o < 2048; o += 512) { const int b = o >> 6, col = o & 63; float sacc = 0.f;
#pragma unroll
        for (int w = 0; w < 8; ++w) sacc += red[(w * 32 + b) * 64 + col];
        mod[(size_t)b * 3072 + cb * 64 + col] = sacc + bias[cb * 64 + col]; }
    __syncthreads();
}

__device__ __forceinline__ void norm_rows(const float* src, const float* g, const float* mod, bf16raw* H, int grow0, int lrow0, int nrows, int lane) {
    const int b = grow0 >> 11;
    f32x4 mul[4], add[4];
#pragma unroll
    for (int j = 0; j < 4; ++j) { const f32x4 gg = *(const f32x4*)(g + 4 * lane + 256 * j), sc = *(const f32x4*)(mod + (size_t)b * 3072 + 1024 + 4 * lane + 256 * j);
        mul[j] = gg * (sc + 1.0f); add[j] = *(const f32x4*)(mod + (size_t)b * 3072 + 4 * lane + 256 * j); }
    for (int r = 0; r < nrows; ++r) {
        const f32x4* xr = (const f32x4*)(src + (size_t)(grow0 + r) * DM) + lane;
        f32x4 v[4]; float s = 0.f;
#pragma unroll
        for (int j = 0; j < 4; ++j) { v[j] = xr[64 * j]; s += (v[j].x * v[j].x + v[j].y * v[j].y) + (v[j].z * v[j].z + v[j].w * v[j].w); }
        const float rstd = 1.0f / sqrtf(wave_sum(s) * (1.0f / DM) + NORM_EPS);
        unsigned long long* o8 = (unsigned long long*)(H + (size_t)(lrow0 + r) * DM) + lane;
#pragma unroll
        for (int j = 0; j < 4; ++j) { const f32x4 y = v[j] * rstd * mul[j] + add[j];
            o8[64 * j] = (unsigned long long)pk2(y.x, y.y) | ((unsigned long long)pk2(y.z, y.w) << 32); }
    }
}
__device__ __forceinline__ void final_norm_rows(float* out, const float* g, int row0, int nrows, int lane) {
    f32x4 mul[4];
#pragma unroll
    for (int j = 0; j < 4; ++j) mul[j] = *(const f32x4*)(g + 4 * lane + 256 * j);
    for (int r = 0; r < nrows; ++r) {
        f32x4* xr = (f32x4*)(out + (size_t)(row0 + r) * DM) + lane;
        f32x4 v[4]; float s = 0.f;
#pragma unroll
        for (int j = 0; j < 4; ++j) { v[j] = xr[64 * j]; s += (v[j].x * v[j].x + v[j].y * v[j].y) + (v[j].z * v[j].z + v[j].w * v[j].w); }
        const float rstd = 1.0f / sqrtf(wave_sum(s) * (1.0f / DM) + NORM_EPS);
#pragma unroll
        for (int j = 0; j < 4; ++j) xr[64 * j] = v[j] * rstd * mul[j];
    }
}

__device__ __forceinline__ void fox_prep(const float* lf, const bf16raw* K, int tok0, int h, LAS unsigned char* lds, int tid) {
    LAS float* cum = (LAS float*)(lds + att::L_CUM); LAS float* tot = (LAS float*)(lds + att::L_WSF); LAS unsigned* misc = (LAS unsigned*)(lds + att::L_MISC);
    __syncthreads();
    const int lane = tid & 63, wave = tid >> 6;
    const float* p = lf + (size_t)(tok0 + 4 * tid) * 32 + h;
    float a0 = p[0], a1 = p[32], a2 = p[64], a3 = p[96];
    float km = 0.f;
#pragma unroll
    for (int kk = 0; kk < 4; ++kk) { const v4u* rowp = (const v4u*)(K + (size_t)(tok0 + 4 * tid + kk) * 2048 + h * 64); float n2 = 0.f;
#pragma unroll
        for (int c = 0; c < 8; ++c) { const v4u w = rowp[c];
#pragma unroll
            for (int e = 0; e < 4; ++e) { const float lo = __uint_as_float(w[e] << 16), hi = __uint_as_float(w[e] & 0xffff0000u); n2 += lo * lo + hi * hi; } }
        km = fmaxf(km, n2); }
#pragma unroll
    for (int o = 1; o < 64; o <<= 1) km = fmaxf(km, __shfl_xor(km, o));
    a1 += a0; a2 += a1; a3 += a2;
    float inc = a3;
#pragma unroll
    for (int o = 1; o < 64; o <<= 1) { const float t = __shfl_up(inc, o); if (lane >= o) inc += t; }
    if (lane == 63) tot[wave] = inc;
    if (lane == 0) tot[8 + wave] = km;
    __syncthreads();
    float base = inc - a3;
    for (int w = 0; w < wave; ++w) base += tot[w];
    *(LAS f32x4*)(cum + 4 * tid) = (f32x4){a0 + base, a1 + base, a2 + base, a3 + base};
    if (tid == 0) { float mm = tot[8];
#pragma unroll
        for (int w = 1; w < 8; ++w) mm = fmaxf(mm, tot[8 + w]);
        misc[1] = __float_as_uint(sqrtf(mm)); }
    __syncthreads();
}

__device__ __forceinline__ int fresh_tid() { int t = threadIdx.x; asm volatile("" : "+v"(t)); return t; }
#define CAS __attribute__((address_space(4)))
__device__ __forceinline__ const CAS Params* launder(const CAS Params* q) { asm volatile("" : "+s"(q)); return q; }
#define PP (launder(kp0))
__global__ void __launch_bounds__(NWAVES * 64) mega_fwd(Params p_kernarg) {
    const CAS Params* const kp0 = (const CAS Params*)__builtin_amdgcn_kernarg_segment_ptr();
    extern __shared__ __attribute__((aligned(16))) unsigned char lds_raw[];
    cg::grid_group grid = cg::this_grid();
    LAS unsigned char* lds = (LAS unsigned char*)lds_raw;
    const int G = gridDim.x, bx = blockIdx.x; const int vcu = (G % 8 == 0) ? (bx % 8) * (G / 8) + bx / 8 : bx;
#define WIN_T(l) ((bf16raw*)(PP->ws + ((l) ? WS_WIN1 : WS_WIN0)))
#define WOUT_T(l) ((bf16raw*)(PP->ws + ((l) ? WS_WOUT1 : WS_WOUT0)))
#define MOD_ ((float*)(PP->ws + WS_MOD))
#define LF_ ((float*)(PP->ws + WS_LOGF))
#define H_ ((bf16raw*)(PP->ws + WS_H))
#define QB_ ((bf16raw*)(PP->ws + WS_Q))

    {
        const int tid = fresh_tid(), lane = tid & 63, wave = __builtin_amdgcn_readfirstlane(tid >> 6);
        LAS float* scr = (LAS float*)(lds + wave * 16384);
        const int gw = vcu * NWAVES + wave, NGW = G * NWAVES;
        constexpr int I_IN0 = 16 * (NIN0_REAL / 32), I_IN1 = 16 * (NIN1 / 32), I_OUT = 32 * 32;
        constexpr int NITEMS = I_IN0 + I_IN1 + 2 * I_OUT;
        for (int it = gw; it < NITEMS; it += NGW) {
            int r = it;
            if (r < I_IN0) { transpose_item(PP->fwin, DM, NIN0_REAL, WIN_T(0), scr, r, lane); continue; } r -= I_IN0;
            if (r < I_IN1) { transpose_item(PP->swin, DM, NIN1, WIN_T(1), scr, r, lane); continue; } r -= I_IN1;
            if (r < I_OUT) { transpose_item(PP->fwout, DI, DM, WOUT_T(0), scr, r, lane); continue; } r -= I_OUT;
            transpose_item(PP->swout, DI, DM, WOUT_T(1), scr, r, lane);
        }
        { v4u* z = (v4u*)(WIN_T(0) + (size_t)NIN0_REAL * DM); const int n16 = (NIN0 - NIN0_REAL) * DM * 2 / 16;
          for (int i = bx * 512 + tid; i < n16; i += G * 512) z[i] = (v4u){0u, 0u, 0u, 0u}; }
        if (bx == 0 && tid < 4) ((unsigned*)(PP->ws + WS_CNT))[16 * tid] = 0u;
        __syncthreads();
        for (int it = bx; it < 96; it += G) { const int l = it / 48, cb = it % 48;
            ada_item(PP->c, l ? PP->swada : PP->fwada, l ? PP->sbada : PP->fbada, MOD_ + (size_t)l * NB * 3072, cb, lds, tid); }
    }
    grid.sync();
    const int rows_per_wave = CH / (G * NWAVES);
#define NORM_PHASE(l, ch) do { const int tid = fresh_tid(), lane = tid & 63, wave = __builtin_amdgcn_readfirstlane(tid >> 6); const int lr0 = (vcu * NWAVES + wave) * rows_per_wave; \
        norm_rows((l) ? PP->out : PP->x, (l) ? PP->sng : PP->fng, MOD_ + (size_t)(l) * NB * 3072, H_, (ch) * CH + lr0, lr0, rows_per_wave, lane); } while (0)
    NORM_PHASE(0, 0);
    grid.sync();
    auto layer_chunk = [&](auto LC, auto CC) __attribute__((always_inline)) {
        constexpr int l = decltype(LC)::value, ch = decltype(CC)::value;
            {
                pg8::Gemm g{H_, WIN_T(l), CH, l ? NIN1 : NIN0, DM}; pg8::StaticOrder S; S.init(CH, l ? NIN1 : NIN0, G, bx);
                pg8::EpiProj E{QB_, QKVZ_STRIDE, att::C2, LF_, PP->fbf};
                pg8::gemm_phase<pg8::EpiProj, pg8::StaticOrder, true, true>(lds, g, S, E);
            }
            grid.sync();
            {
                const att::bf16* Qp = (const att::bf16*)QB_; const att::bf16* Kp = Qp + QKVZ_STRIDE; const att::bf16* Vp = Kp + QKVZ_STRIDE; const att::bf16* Zp = Vp + QKVZ_STRIDE;
                LAS unsigned* misc = (LAS unsigned*)(lds + att::L_MISC); const int tid = fresh_tid();
                if (tid < 32) { unsigned rank = tid;
                    if (l == 0) { const float* bfp = PP->fbf; const float mine = bfp[tid]; rank = 0; for (int j = 0; j < 32; ++j) { const float o = bfp[j]; rank += (o > mine || (o == mine && j < tid)) ? 1u : 0u; } }
                    misc[32 + rank] = tid; }
                __syncthreads();
                unsigned* counter = (unsigned*)(PP->ws + WS_CNT) + 16 * (l * NCHUNK + ch);
                for (;;) {
                    if (tid == 0) misc[0] = atomicAdd(counter, 1u);
                    __syncthreads();
                    const int it = __builtin_amdgcn_readfirstlane(misc[0]);
                    if (it >= CHB * NH) break;
                    const int h = __builtin_amdgcn_readfirstlane(misc[32 + it / CHB]), tok0 = (it % CHB) * SEQ;
                    if (l == 0) { fox_prep(LF_, (const bf16raw*)Kp, tok0, h, lds, tid);
                        for (int qb = att::NQB - 1; qb >= 0; --qb) att::unit<0>(tok0, h, qb, Qp, Kp, Vp, Zp, (att::bf16*)QB_, (LAS char*)lds); }
                    else { for (int qb = att::NQB - 1; qb >= 0; --qb) att::unit<1>(tok0, h, qb, Qp, Kp, Vp, Zp, (att::bf16*)QB_, (LAS char*)lds); }
                }
                asm volatile("s_waitcnt vmcnt(0) lgkmcnt(0)" ::: "memory"); __syncthreads();
            }
            grid.sync();
            {
                pg8::Gemm g{QB_, WOUT_T(l), CH, DM, DI}; pg8::StaticOrder S; S.init(CH, DM, G, bx);
                pg8::EpiRes E{l ? PP->out : PP->x, PP->out, MOD_ + (size_t)l * NB * 3072 + 2048, ch * CH};
                pg8::gemm_phase<pg8::EpiRes, pg8::StaticOrder, true, true>(lds, g, S, E);
            }
            if (ch + 1 < NCHUNK) NORM_PHASE(l, ch + 1);
            else if (l == 0) NORM_PHASE(1, 0);
            grid.sync();
    };
    layer_chunk(std::integral_constant<int, 0>{}, std::integral_constant<int, 0>{});
    layer_chunk(std::integral_constant<int, 0>{}, std::integral_constant<int, 1>{});
    layer_chunk(std::integral_constant<int, 1>{}, std::integral_constant<int, 0>{});
    layer_chunk(std::integral_constant<int, 1>{}, std::integral_constant<int, 1>{});
    { const int tid = fresh_tid(), lane = tid & 63, wave = __builtin_amdgcn_readfirstlane(tid >> 6); const int rpw = MTOK / (G * NWAVES); final_norm_rows(PP->out, PP->fing, (vcu * NWAVES + wave) * rpw, rpw, lane); }
}

extern "C" void kernel_launch(void* const* d_in, const int* in_sizes, int n_in, void* d_out, int out_size, void* d_ws, size_t ws_size, hipStream_t stream) {
    static int grid = 0;
    if (grid == 0) {
        if (n_in != 14 || in_sizes[0] != MTOK * DM || out_size != MTOK * DM || ws_size < WS_END) { fprintf(stderr, "kernel_launch: unexpected shapes (n_in %d, in0 %d, out %d, ws %zu < %zu); nothing launched\n", n_in, n_in > 0 ? in_sizes[0] : -1, out_size, ws_size, (size_t)WS_END); grid = -1; return; }
        int dev = 0, cus = 0, per_cu = 0;
        if (hipGetDevice(&dev) != hipSuccess || hipDeviceGetAttribute(&cus, hipDeviceAttributeMultiprocessorCount, dev) != hipSuccess) { grid = -1; return; }
        if (hipFuncSetAttribute((const void*)mega_fwd, hipFuncAttributeMaxDynamicSharedMemorySize, LDS_BYTES) != hipSuccess) { fprintf(stderr, "kernel_launch: hipFuncSetAttribute failed\n"); grid = -1; return; }
        if (hipOccupancyMaxActiveBlocksPerMultiprocessor(&per_cu, (const void*)mega_fwd, NWAVES * 64, LDS_BYTES) != hipSuccess || per_cu < 1) { fprintf(stderr, "kernel_launch: occupancy query gave %d\n", per_cu); per_cu = 1; }
        (void)hipGetLastError();
        grid = cus * per_cu;
        if (CH % (grid * NWAVES) != 0 || grid % 8 != 0) { fprintf(stderr, "kernel_launch: grid %d does not divide the row split\n", grid); grid = -1; return; }
    }
    if (grid < 0) return;
    Params p{};
    p.x = (const float*)d_in[0]; p.c = (const float*)d_in[1]; p.fng = (const float*)d_in[2]; p.fwada = (const float*)d_in[3]; p.fbada = (const float*)d_in[4];
    p.fwin = (const float*)d_in[5]; p.fbf = (const float*)d_in[6]; p.fwout = (const float*)d_in[7]; p.sng = (const float*)d_in[8]; p.swada = (const float*)d_in[9];
    p.sbada = (const float*)d_in[10]; p.swin = (const float*)d_in[11]; p.swout = (const float*)d_in[12]; p.fing = (const float*)d_in[13];
    p.out = (float*)d_out; p.ws = (unsigned char*)d_ws;
    void* args[] = {&p};
    hipError_t e = hipLaunchCooperativeKernel((const void*)mega_fwd, dim3(grid), dim3(NWAVES * 64), args, LDS_BYTES, stream);
    if (e != hipSuccess) fprintf(stderr, "kernel_launch: cooperative launch failed: %s (grid %d)\n", hipGetErrorString(e), grid);
}
```

```cpp
#include <hip/hip_runtime.h>
#include <hip/hip_cooperative_groups.h>
#include <hip/hip_bf16.h>
#include <cstdio>
#include <cstdint>
#include <cmath>
#include <type_traits>
namespace cg = cooperative_groups;
namespace pg8 {
#define PG8_LAS __attribute__((address_space(3)))
typedef unsigned short bf16_t;
typedef short bf16x8 __attribute__((ext_vector_type(8)));
typedef float f32x4 __attribute__((ext_vector_type(4)));
typedef unsigned u32x4 __attribute__((ext_vector_type(4)));
constexpr int BM = 256, BK = 64, HALF = 128, HTB = HALF * BK * 2  , STAGE_BYTES = 8 * HTB, NXCD = 8, WGM = 4;

__host__ __device__ __forceinline__ int lds_byte(int r, int c) { const int st = (r >> 4) * 2 + (c >> 5), rr = r & 15, cc = c & 31, ob = rr * 64 + cc * 2; return st * 1024 + (ob ^ (((ob >> 9) & 1) << 5)); }
__host__ __device__ __forceinline__ void stage_rc(int b, int& R, int& C) { const int st = b / 1024, sb = b % 1024, swz = sb ^ (((sb >> 9) & 1) << 5); R = (st >> 1) * 16 + swz / 64; C = (st & 1) * 32 + (swz % 64) / 2; }
__host__ __device__ __forceinline__ int perm32(int rho) { const int n = rho >> 4, i = rho & 15; return 8 * (i >> 2) + 4 * n + (i & 3); }

struct Unit { int pm, pn; };
struct Gemm { const bf16_t* A; const bf16_t* Bt; int M, N, K; };

struct StaticOrder {
    int nM, nN, nwg, G, c;
    __host__ __device__ void init(int M, int N, int G_, int c_) { nM = M / BM; nN = N / BM; nwg = nM * nN; G = G_; c = c_; }
    __host__ __device__ bool next(int i, Unit& u) const {
        const long L = (long)i * G + c; if (L >= nwg) return false;
        int wgid = (int)L; { const int q = nwg / NXCD, r = nwg % NXCD, xcd = wgid % NXCD, off = wgid / NXCD; wgid = (xcd < r ? xcd * (q + 1) : r * (q + 1) + (xcd - r) * q) + off; }
        const int nig = WGM * nN, gid = wgid / nig, fm = gid * WGM, gsz = (nM - fm) < WGM ? (nM - fm) : WGM;
        u.pm = fm + ((wgid % nig) % gsz); u.pn = (wgid % nig) / gsz; return true;
    }
    __device__ __forceinline__ void a_ready(const Unit&) const {}
    __device__ __forceinline__ void done(const Unit&) const {}
};

__device__ __forceinline__ unsigned cvt_pk_bf16(float lo, float hi) { unsigned r; asm volatile("v_cvt_pk_bf16_f32 %0, %1, %2" : "=v"(r) : "v"(lo), "v"(hi)); return r; }
typedef float f32x2 __attribute__((ext_vector_type(2)));
typedef float f32x2 __attribute__((ext_vector_type(2)));
struct EpiProj {
    static constexpr bool PERM = true, AFTER_DRAIN = false;
    bf16_t* O; size_t split_stride; float scale0; float* lf; const float* bf; unsigned* kmx;
    __device__ __forceinline__ void operator()(const f32x4 (&acc)[2][2][4][2], const Unit& u, int wr, int wc, int fr, int fq) const {
        const int t = u.pn >> 3;
        const int row0 = u.pm * BM + wr * 64 + fr;
        if (t < 4) {
            bf16_t* base = O + (size_t)t * split_stride; const float sc = (t == 0) ? scale0 : 1.f;
            const int bl = u.pm >> 3, s0 = (u.pm & 7) * BM + wr * 64 + fr, dcol = (wc & 1) * 32 + 8 * fq;
            float kss[2][8];
#pragma unroll
            for (int bj = 0; bj < 2; ++bj) { const int hd = (u.pn & 7) * 4 + bj * 2 + (wc >> 1); bf16_t* hp = base + ((size_t)(bl * 32 + hd) * 2048 + s0) * 64 + dcol;
#pragma unroll
                for (int ai = 0; ai < 2; ++ai)
#pragma unroll
                    for (int m = 0; m < 4; ++m) { f32x4 v0 = acc[ai][bj][m][0], v1 = acc[ai][bj][m][1]; if (t == 0) { v0 = v0 * sc; v1 = v1 * sc; }
                        u32x4 w; w.x = cvt_pk_bf16(v0[0], v0[1]); w.y = cvt_pk_bf16(v0[2], v0[3]); w.z = cvt_pk_bf16(v1[0], v1[1]); w.w = cvt_pk_bf16(v1[2], v1[3]);
                        *(u32x4*)(hp + (size_t)(ai * HALF + m * 16) * 64) = w;
                        if (t == 1 && kmx) { float ss = 0.f;
#pragma unroll
                            for (int e_ = 0; e_ < 4; ++e_) { const float lo_ = __uint_as_float(w[e_] << 16), hi_ = __uint_as_float(w[e_] & 0xffff0000u); ss += lo_ * lo_ + hi_ * hi_; }
                            kss[bj][ai * 4 + m] = ss; } } }
            if (t == 1 && kmx) {
#pragma unroll
                for (int bj = 0; bj < 2; ++bj) { float mx = 0.f;
#pragma unroll
                    for (int q = 0; q < 8; ++q) { float ss = kss[bj][q]; ss += __shfl_xor(ss, 16); ss += __shfl_xor(ss, 32); mx = fmaxf(mx, ss); }
#pragma unroll
                    for (int o = 1; o < 16; o <<= 1) mx = fmaxf(mx, __shfl_xor(mx, o));
                    if (fr == 0 && fq == 0) atomicMax(kmx + ((bl * 32 + (u.pn & 7) * 4 + bj * 2 + (wc >> 1)) * 2 + (wc & 1)), __float_as_uint(mx)); }
            }
        } else if (wc == 0) {
            f32x4 bv[2];
#pragma unroll
            for (int n = 0; n < 2; ++n) bv[n] = *(const f32x4*)(bf + 8 * fq + 4 * n);
#pragma unroll
            for (int ai = 0; ai < 2; ++ai)
#pragma unroll
                for (int m = 0; m < 4; ++m) { float* rowp = lf + (size_t)(row0 + ai * HALF + m * 16) * 32 + 8 * fq;
#pragma unroll
                    for (int n = 0; n < 2; ++n) { f32x4 v = acc[ai][0][m][n] + bv[n]; f32x4 o;
#pragma unroll
                        for (int e = 0; e < 4; ++e) { const float xx = v[e]; o[e] = (fminf(xx, 0.f) - log1pf(__expf(-fabsf(xx)))) * 1.4426950408889634f; }
                        *(f32x4*)(rowp + 4 * n) = o; } }
        }
    }
};
template <bool BASE_BF>
struct EpiRes {
    static constexpr bool PERM = true, AFTER_DRAIN = false;
    const void* base; bf16_t* outb; const float* gate; int row_off;
    __device__ __forceinline__ void operator()(const f32x4 (&acc)[2][2][4][2], const Unit& u, int wr, int wc, int fr, int fq) const {
        const int col0 = u.pn * BM + wc * 32 + 8 * fq; const int b = (row_off + u.pm * BM) >> 11;
        f32x4 gv[2][2];
#pragma unroll
        for (int bj = 0; bj < 2; ++bj)
#pragma unroll
            for (int n = 0; n < 2; ++n) gv[bj][n] = *(const f32x4*)(gate + (size_t)b * 3072 + col0 + bj * HALF + 4 * n);
#pragma unroll
        for (int ai = 0; ai < 2; ++ai)
#pragma unroll
            for (int m = 0; m < 4; ++m) { const size_t off = (size_t)(row_off + u.pm * BM + wr * 64 + fr + ai * HALF + m * 16) * 1024 + col0;
#pragma unroll
                for (int bj = 0; bj < 2; ++bj) { f32x4 b0, b1;
                    if (BASE_BF) { const u32x4 w = *(const u32x4*)((const bf16_t*)base + off + bj * HALF);
                        b0 = (f32x4){__uint_as_float(w.x << 16), __uint_as_float(w.x & 0xffff0000u), __uint_as_float(w.y << 16), __uint_as_float(w.y & 0xffff0000u)};
                        b1 = (f32x4){__uint_as_float(w.z << 16), __uint_as_float(w.z & 0xffff0000u), __uint_as_float(w.w << 16), __uint_as_float(w.w & 0xffff0000u)}; }
                    else { b0 = *(const f32x4*)((const float*)base + off + bj * HALF); b1 = *(const f32x4*)((const float*)base + off + bj * HALF + 4); }
                    const f32x4 v0 = b0 + gv[bj][0] * acc[ai][bj][m][0], v1 = b1 + gv[bj][1] * acc[ai][bj][m][1];
                    u32x4 o; o.x = cvt_pk_bf16(v0[0], v0[1]); o.y = cvt_pk_bf16(v0[2], v0[3]); o.z = cvt_pk_bf16(v1[0], v1[1]); o.w = cvt_pk_bf16(v1[2], v1[3]);
                    *(u32x4*)(outb + off + bj * HALF) = o; } }
    }
};
template <class Epi, class Sched, bool ALIGN_EPI = false, bool SP2 = false, bool AHM = false>
__device__ __forceinline__ void gemm_phase(PG8_LAS unsigned char* lds, const Gemm g, const Sched& S, const Epi& E, int tid_in) {
    const int tid = tid_in, wid = __builtin_amdgcn_readfirstlane(tid >> 6), lane = tid & 63, wr = wid >> 2, wc = wid & 3, fr = lane & 15, fq = lane >> 4;
    const int K = g.K, nt = K / BK;
    unsigned voffA[2], voffB[2];
#pragma unroll
    for (int i = 0; i < 2; ++i) { int R, C; stage_rc(tid * 16 + i * 8192, R, C); const int Rb = Epi::PERM ? ((R & ~31) + perm32(R & 31)) : R;
        voffA[i] = (unsigned)(R * (AHM ? 64 : K) + C) * 2u; voffB[i] = (unsigned)(Rb * K + C) * 2u; }
    const size_t kstep = (size_t)(BK * 2);
    const size_t hstep = (size_t)HALF * K * 2;
    const size_t tstep = 2 * hstep;
    const size_t kstepA = AHM ? (size_t)2048 * 128 : kstep, hstepA = AHM ? (size_t)HALF * 128 : hstep;
#define PG8_ATILE(pm_) ((const char*)g.A + (AHM ? ((size_t)((pm_) >> 3) * 32 * 2048 + (size_t)((pm_) & 7) * 256) * 128 : (size_t)(pm_) * tstep))
    const unsigned ldsw = (unsigned)wid * 1024u;
    const int aoff = lds_byte(wr * 64 + fr, fq * 8), boff = lds_byte(wc * 32 + fr, fq * 8);
#define PG8_SA(b, h) (((b) * 2 + (h)) * HTB)
#define PG8_SB(b, h) ((4 + (b) * 2 + (h)) * HTB)
#define PG8_STAGE(bufoff, gbase, voff) do { _Pragma("unroll") for (int _i = 0; _i < 2; ++_i) \
        __builtin_amdgcn_global_load_lds((const unsigned*)((const char*)(gbase) + (voff)[_i]), (PG8_LAS unsigned*)(lds + (bufoff) + ldsw + _i * 8192), 16, 0, 0); } while (0)
#define PG8_LDA(dst, b, h) do { _Pragma("unroll") for (int m = 0; m < 4; ++m) _Pragma("unroll") for (int k = 0; k < 2; ++k) dst[m][k] = *(const PG8_LAS bf16x8*)(lds + PG8_SA(b, h) + aoff + m * 2048 + k * 1024); } while (0)
#define PG8_LDB(dst, b, h) do { _Pragma("unroll") for (int n = 0; n < 2; ++n) _Pragma("unroll") for (int k = 0; k < 2; ++k) dst[n][k] = *(const PG8_LAS bf16x8*)(lds + PG8_SB(b, h) + boff + n * 2048 + k * 1024); } while (0)
#define PG8_MMA(ai, bj, At, Bt) do { __builtin_amdgcn_s_setprio(1); _Pragma("unroll") for (int m = 0; m < 4; ++m) _Pragma("unroll") for (int n = 0; n < 2; ++n) _Pragma("unroll") for (int k = 0; k < 2; ++k) \
        acc[ai][bj][m][n] = __builtin_amdgcn_mfma_f32_16x16x32_bf16(Bt[n][k], At[m][k], acc[ai][bj][m][n], 0, 0, 0); __builtin_amdgcn_s_setprio(0); } while (0)
#define PG8_WAIT_V(n) asm volatile("s_waitcnt vmcnt(" #n ")" ::: "memory")
#define PG8_WAIT_L(n) asm volatile("s_waitcnt lgkmcnt(" #n ")" ::: "memory")
#define PG8_BAR __builtin_amdgcn_s_barrier()
#define PG8_SCHED __builtin_amdgcn_sched_barrier(0)
    Unit cur, nxt; int ui = 0;
    if (!S.next(0, cur)) return;
    f32x4 acc[2][2][4][2];
#pragma unroll
    for (int a = 0; a < 2; ++a)
#pragma unroll
        for (int b = 0; b < 2; ++b)
#pragma unroll
            for (int m = 0; m < 4; ++m)
#pragma unroll
                for (int n = 0; n < 2; ++n) acc[a][b][m][n] = (f32x4){0.f, 0.f, 0.f, 0.f};
    bf16x8 At[4][2], B0[2][2], B1[2][2];
    const char* cA = PG8_ATILE(cur.pm); const char* cB = (const char*)g.Bt + (size_t)cur.pn * tstep;
    S.a_ready(cur);
    if constexpr (SP2) {
        PG8_STAGE(PG8_SB(0, 0), cB, voffB); PG8_STAGE(PG8_SB(0, 1), cB + hstep, voffB); PG8_STAGE(PG8_SA(0, 0), cA, voffA); PG8_STAGE(PG8_SA(0, 1), cA + hstepA, voffA);
        if (wr == 1) PG8_BAR;
        PG8_WAIT_V(2); PG8_BAR;
        PG8_STAGE(PG8_SB(1, 0), cB + kstep, voffB); PG8_STAGE(PG8_SA(1, 0), cA + kstepA, voffA); PG8_STAGE(PG8_SB(1, 1), cB + hstep + kstep, voffB);
        PG8_WAIT_V(6); PG8_BAR;
    } else {
        PG8_STAGE(PG8_SB(0, 0), cB, voffB); PG8_STAGE(PG8_SA(0, 0), cA, voffA); PG8_STAGE(PG8_SB(0, 1), cB + hstep, voffB); PG8_STAGE(PG8_SA(0, 1), cA + hstepA, voffA);
        if (wr == 1) PG8_BAR;
        PG8_WAIT_V(4); PG8_BAR;
        PG8_STAGE(PG8_SB(1, 0), cB + kstep, voffB); PG8_STAGE(PG8_SA(1, 0), cA + kstepA, voffA); PG8_STAGE(PG8_SB(1, 1), cB + hstep + kstep, voffB);
        PG8_WAIT_V(6); PG8_BAR;
    }
    for (;;) {
        const bool has_next = S.next(ui + 1, nxt);
        const char* nA = has_next ? PG8_ATILE(nxt.pm) : cA; const char* nB = has_next ? (const char*)g.Bt + (size_t)nxt.pn * tstep : cB;
        for (int t = 0; t < nt; t += 2) {
            const bool last = (t == nt - 2);
            const char* a1 = cA + (size_t)(t + 1) * kstepA;
            const char* a2 = last ? nA : cA + (size_t)(t + 2) * kstepA; const char* b2 = last ? nB : cB + (size_t)(t + 2) * kstep;
            const char* a3 = a2 + kstepA; const char* b3 = b2 + kstep;
            if (last && has_next) S.a_ready(nxt);
            if constexpr (SP2) {
            PG8_LDB(B0, 0, 0); PG8_LDB(B1, 0, 1); PG8_SCHED; PG8_LDA(At, 0, 0); PG8_STAGE(PG8_SA(1, 1), a1 + hstepA, voffA);
            PG8_WAIT_V(8); PG8_WAIT_L(0); PG8_BAR; PG8_MMA(0, 0, At, B0); PG8_MMA(0, 1, At, B1); PG8_BAR; PG8_SCHED;
            PG8_LDA(At, 0, 1); PG8_STAGE(PG8_SB(0, 0), b2, voffB); PG8_STAGE(PG8_SB(0, 1), b2 + hstep, voffB); PG8_STAGE(PG8_SA(0, 0), a2, voffA);
            PG8_WAIT_V(8); PG8_WAIT_L(0); PG8_BAR; PG8_MMA(1, 0, At, B0); PG8_MMA(1, 1, At, B1); PG8_BAR; PG8_SCHED;
            PG8_LDB(B0, 1, 0); PG8_LDB(B1, 1, 1); PG8_SCHED; PG8_LDA(At, 1, 0); PG8_STAGE(PG8_SA(0, 1), a2 + hstepA, voffA);
            PG8_WAIT_V(8); PG8_WAIT_L(0); PG8_BAR; PG8_MMA(0, 0, At, B0); PG8_MMA(0, 1, At, B1); PG8_BAR; PG8_SCHED;
            PG8_LDA(At, 1, 1); PG8_STAGE(PG8_SB(1, 0), b3, voffB); PG8_STAGE(PG8_SB(1, 1), b3 + hstep, voffB); PG8_STAGE(PG8_SA(1, 0), a3, voffA);
            PG8_WAIT_V(8); PG8_WAIT_L(0); PG8_BAR; PG8_MMA(1, 0, At, B0); PG8_MMA(1, 1, At, B1); PG8_BAR; PG8_SCHED;
            } else {
            PG8_LDB(B0, 0, 0); PG8_SCHED; PG8_LDA(At, 0, 0); PG8_STAGE(PG8_SA(1, 1), a1 + hstepA, voffA);
            PG8_WAIT_L(8); PG8_BAR; PG8_WAIT_L(0); PG8_MMA(0, 0, At, B0); PG8_BAR; PG8_SCHED;
            PG8_LDB(B1, 0, 1); PG8_STAGE(PG8_SB(0, 0), b2, voffB);
            PG8_BAR; PG8_WAIT_L(0); PG8_MMA(0, 1, At, B1); PG8_BAR;
            PG8_LDA(At, 0, 1); PG8_STAGE(PG8_SA(0, 0), a2, voffA);
            PG8_BAR; PG8_WAIT_L(0); PG8_MMA(1, 0, At, B0); PG8_BAR; PG8_SCHED;
            PG8_STAGE(PG8_SB(0, 1), b2 + hstep, voffB);
            PG8_WAIT_V(6); PG8_BAR; PG8_MMA(1, 1, At, B1); PG8_BAR;
            PG8_LDB(B0, 1, 0); PG8_SCHED; PG8_LDA(At, 1, 0); PG8_STAGE(PG8_SA(0, 1), a2 + hstepA, voffA);
            PG8_WAIT_L(8); PG8_BAR; PG8_WAIT_L(0); PG8_MMA(0, 0, At, B0); PG8_BAR; PG8_SCHED;
            PG8_LDB(B1, 1, 1); PG8_STAGE(PG8_SB(1, 0), b3, voffB);
            PG8_BAR; PG8_WAIT_L(0); PG8_MMA(0, 1, At, B1); PG8_BAR;
            PG8_LDA(At, 1, 1); PG8_STAGE(PG8_SA(1, 0), a3, voffA);
            PG8_BAR; PG8_WAIT_L(0); PG8_MMA(1, 0, At, B0); PG8_BAR; PG8_SCHED;
            PG8_STAGE(PG8_SB(1, 1), b3 + hstep, voffB);
            PG8_WAIT_V(6); PG8_BAR; PG8_MMA(1, 1, At, B1); PG8_BAR;
            }
        }
        if constexpr (ALIGN_EPI) { if (wr == 0) PG8_BAR; }
        if constexpr (!Epi::AFTER_DRAIN) { E(acc, cur, wr, wc, fr, fq); S.done(cur); }
        if (!has_next) break;
#pragma unroll
        for (int a = 0; a < 2; ++a)
#pragma unroll
            for (int b = 0; b < 2; ++b)
#pragma unroll
                for (int m = 0; m < 4; ++m)
#pragma unroll
                    for (int n = 0; n < 2; ++n) acc[a][b][m][n] = (f32x4){0.f, 0.f, 0.f, 0.f};
        cur = nxt; cA = nA; cB = nB; ++ui;
        if constexpr (ALIGN_EPI) { if (wr == 1) PG8_BAR; }
    }
    PG8_WAIT_V(0);
    if constexpr (!ALIGN_EPI) { if (wr == 0) PG8_BAR; }
    PG8_BAR;
    if constexpr (Epi::AFTER_DRAIN) { E.fused(acc, cur, wr, wc, fr, fq, lds, wid, lane); S.done(cur); }
#undef PG8_SA
#undef PG8_ATILE
#undef PG8_SB
#undef PG8_STAGE
#undef PG8_LDA
#undef PG8_LDB
#undef PG8_MMA
#undef PG8_WAIT_V
#undef PG8_WAIT_L
#undef PG8_BAR
#undef PG8_SCHED
}
}
namespace att {
typedef __hip_bfloat16 bf16;
typedef __attribute__((ext_vector_type(8))) short bf16x8;
typedef __attribute__((ext_vector_type(4))) short s16x4;
typedef __attribute__((ext_vector_type(16))) float f32x16;
typedef __attribute__((ext_vector_type(4))) float f32x4;
typedef __attribute__((ext_vector_type(4))) unsigned u32x4;
typedef __attribute__((ext_vector_type(2))) unsigned u32x2;
#define ALAS __attribute__((address_space(3)))
constexpr int PITCH = 64, SEQ = 2048, D = 64, QB = 256, KVB = 64, NQB = SEQ / QB;
constexpr int SLOTB = 16384, NSLOT = 6;
constexpr int L_CUM = NSLOT * SLOTB, L_WSF = L_CUM + SEQ * 4, L_MISC = L_WSF + 8 * 256, L_OST = L_MISC + 256, L_END = L_OST + 8 * 4096;
constexpr float C2 = 0.125f * 1.4426950408889634f;
__device__ __forceinline__ int crow(int r, int hi) { return (r & 3) + 8 * (r >> 2) + 4 * hi; }
__device__ __forceinline__ void glds16(const void* gsrc, unsigned lds_dst) { unsigned keep;
  asm volatile("s_mov_b32 %0, m0\n\ts_mov_b32 m0, %2\n\ts_nop 0\n\tglobal_load_lds_dwordx4 %1, off\n\ts_mov_b32 m0, %0" : "=&s"(keep) : "v"(gsrc), "s"(lds_dst) : "memory"); }
typedef float f32x2_t __attribute__((ext_vector_type(2))); typedef __bf16 bf16x2_t __attribute__((ext_vector_type(2)));
__device__ __forceinline__ unsigned cvtpk(float lo, float hi) { f32x2_t v = {lo, hi}; bf16x2_t b = __builtin_convertvector(v, bf16x2_t); return __builtin_bit_cast(unsigned, b); }
typedef short v4i16_t __attribute__((ext_vector_type(4)));
__device__ __forceinline__ s16x4 vtr(const ALAS char* p) { return __builtin_bit_cast(s16x4, __builtin_amdgcn_ds_read_tr16_b64_v4i16((ALAS v4i16_t*)p)); }
__device__ __forceinline__ float swap_sum(float v) { auto rr = __builtin_amdgcn_permlane32_swap(__float_as_uint(v), __float_as_uint(v), false, false); return __uint_as_float(rr[0]) + __uint_as_float(rr[1]); }
__device__ __forceinline__ float swap_max(float v) { auto rr = __builtin_amdgcn_permlane32_swap(__float_as_uint(v), __float_as_uint(v), false, false); return fmaxf(__uint_as_float(rr[0]), __uint_as_float(rr[1])); }
#define AWAIT_BAR(N) asm volatile("s_waitcnt vmcnt(" #N ") lgkmcnt(0)\n\ts_barrier" ::: "memory")

struct St { f32x16 o0, o1; float mhat, l, R; };
#define SCHED_FENCE() __builtin_amdgcn_sched_barrier(0)

__device__ __forceinline__ void k_frags(bf16x8 (&kf)[4], const ALAS char* kph, int kx) {
  asm volatile("" : "+v"(kx));
#pragma unroll
  for (int d0 = 0; d0 < 4; ++d0) kf[d0] = *(const ALAS bf16x8*)(kph + (kx ^ (d0 << 5)));
}
__device__ __forceinline__ void qk_half(f32x16& p, const bf16x8 (&kf)[4], const bf16x8* qr, const f32x16& c) {
  p = __builtin_amdgcn_mfma_f32_32x32x16_bf16(kf[0], qr[0], c, 0, 0, 0);
#pragma unroll
  for (int d0 = 1; d0 < 4; ++d0) p = __builtin_amdgcn_mfma_f32_32x32x16_bf16(kf[d0], qr[d0], p, 0, 0, 0);
}
struct VF { bf16x8 v[2][2]; };
__device__ __forceinline__ void v_frags(VF& f, const ALAS char* vph) {
#pragma unroll
  for (int k2 = 0; k2 < 2; ++k2) {
    const s16x4 a0 = vtr(vph + k2 * 2048), a1 = vtr(vph + k2 * 2048 + 1024), b0 = vtr(vph + 512 + k2 * 2048), b1 = vtr(vph + 512 + k2 * 2048 + 1024);
    f.v[k2][0] = (bf16x8){a0[0], a0[1], a0[2], a0[3], a1[0], a1[1], a1[2], a1[3]};
    f.v[k2][1] = (bf16x8){b0[0], b0[1], b0[2], b0[3], b1[0], b1[1], b1[2], b1[3]};
  }
}
__device__ __forceinline__ void pv_half(St& s, const VF& f, const f32x16& p) {
  const u32x4 pw0 = (u32x4){cvtpk(p[0], p[1]), cvtpk(p[2], p[3]), cvtpk(p[4], p[5]), cvtpk(p[6], p[7])};
  const u32x4 pw1 = (u32x4){cvtpk(p[8], p[9]), cvtpk(p[10], p[11]), cvtpk(p[12], p[13]), cvtpk(p[14], p[15])};
  s.o0 = __builtin_amdgcn_mfma_f32_32x32x16_bf16(__builtin_bit_cast(bf16x8, pw0), f.v[0][0], s.o0, 0, 0, 0);
  s.o1 = __builtin_amdgcn_mfma_f32_32x32x16_bf16(__builtin_bit_cast(bf16x8, pw0), f.v[0][1], s.o1, 0, 0, 0);
  s.o0 = __builtin_amdgcn_mfma_f32_32x32x16_bf16(__builtin_bit_cast(bf16x8, pw1), f.v[1][0], s.o0, 0, 0, 0);
  s.o1 = __builtin_amdgcn_mfma_f32_32x32x16_bf16(__builtin_bit_cast(bf16x8, pw1), f.v[1][1], s.o1, 0, 0, 0);
}

template <bool STRICT>
__device__ __forceinline__ void tri_mask(f32x16& P, int rr, int hi) {
  float t = ((float)(rr - 4 * hi) + (STRICT ? -0.5f : 0.5f)) * 0x1p100f;
#pragma unroll
  for (int r = 0; r < 16; ++r) { P[r] = fminf(P[r], t); t -= ((r & 3) == 3) ? 5.0f * 0x1p100f : 0x1p100f; }
}

template <bool TRI, bool FIRST>
__device__ __forceinline__ float fox_soft(St& s, f32x16& p, int rr, int hi, int r32, ALAS float* wsf) {
  if (TRI) tri_mask<false>(p, rr, hi);
  float a = fmaxf(p[0], p[1]);
#pragma unroll
  for (int r = 2; r < 16; ++r) a = fmaxf(a, p[r]);
  const float rm = swap_max(a);
  float dl = 0.f;
  if (FIRST) {
    dl = rm; s.mhat += rm;
#pragma unroll
    for (int r = 0; r < 16; ++r) p[r] -= rm;
  } else if (__any(rm > 8.0f)) {
    dl = fmaxf(rm, 0.f); s.mhat += dl;
#pragma unroll
    for (int r = 0; r < 16; ++r) p[r] -= dl;
    const float f = __builtin_amdgcn_exp2f(-dl); s.l *= f;
    if (hi == 0) wsf[r32] = f;
    asm volatile("s_waitcnt lgkmcnt(0)" ::: "memory");
#pragma unroll
    for (int r = 0; r < 16; ++r) { const float fr_ = wsf[crow(r, hi)]; s.o0[r] *= fr_; s.o1[r] *= fr_; }
    asm volatile("s_waitcnt lgkmcnt(0)" ::: "memory");
  }
  float sum = 0.f;
#pragma unroll
  for (int r = 0; r < 16; ++r) { p[r] = __builtin_amdgcn_exp2f(p[r]); sum += p[r]; }
  s.l += sum;
  return dl;
}
template <bool DIAG>
__device__ __forceinline__ void fox_tile(St& s, const ALAS char* kp, int kx, const ALAS char* vp, const bf16x8* qr, const ALAS float* ck, float cq2, int qrel, int hi, int r32, ALAS float* wsf) {
  const float cb = cq2 - s.mhat;
  const bool lowrows = DIAG && (qrel < 32);
  f32x16 p0, p1; bf16x8 kf0[4], kf1[4];
  k_frags(kf0, kp, kx);
  if (!lowrows) {
    k_frags(kf1, kp + 4096, kx);
#pragma unroll
    for (int g = 0; g < 4; ++g) { const f32x4 b = *(const ALAS f32x4*)(ck + 32 + 8 * g + 4 * hi);
#pragma unroll
      for (int i = 0; i < 4; ++i) p1[4 * g + i] = cb - b[i]; }
    qk_half(p1, kf1, qr, p1);
  }
#pragma unroll
  for (int g = 0; g < 4; ++g) { const f32x4 a = *(const ALAS f32x4*)(ck + 8 * g + 4 * hi);
#pragma unroll
    for (int i = 0; i < 4; ++i) p0[4 * g + i] = cb - a[i]; }
  qk_half(p0, kf0, qr, p0);
  SCHED_FENCE();
  VF vf;
  if (!lowrows) {
    v_frags(vf, vp + 4096);
    const float dl = DIAG ? fox_soft<true, true>(s, p1, qrel - 32, hi, r32, wsf) : fox_soft<false, false>(s, p1, 0, hi, r32, wsf);
    SCHED_FENCE();
    pv_half(s, vf, p1);
    if (DIAG || __any(dl != 0.f)) {
#pragma unroll
      for (int r = 0; r < 16; ++r) p0[r] -= dl;
    }
    SCHED_FENCE();
    v_frags(vf, vp);
    fox_soft<false, false>(s, p0, 0, hi, r32, wsf);
  } else {
    v_frags(vf, vp);
    fox_soft<true, true>(s, p0, qrel, hi, r32, wsf);
  }
  SCHED_FENCE();
  pv_half(s, vf, p0);
}

template <bool TRI>
__device__ __forceinline__ void sb_half(f32x16& P, float& Y, int rr, int hi) {
  if (TRI) tri_mask<true>(P, rr, hi);
#pragma unroll
  for (int r = 0; r < 16; ++r) { const float e = __builtin_amdgcn_exp2f(P[r]); P[r] = __builtin_amdgcn_rcpf(1.0f + e); }
#pragma unroll
  for (int g = 3; g >= 0; --g) {
    const float k0 = P[4 * g], k1 = P[4 * g + 1], k2 = P[4 * g + 2], k3 = P[4 * g + 3];
    const float t1 = k3 * k2, t0 = t1 * k1, G = t0 * k0;
    auto rr_ = __builtin_amdgcn_permlane32_swap(__float_as_uint(G), __float_as_uint(G), false, false);
    const float Go = __uint_as_float(rr_[0]), Ge = __uint_as_float(rr_[1]);
    const float Y1 = Y * Ge, Y2 = Y1 * Go;
    const float X = hi ? Y : Y1, XG = hi ? Y1 : Y2;
    const float pe2 = X * k3, pe1 = X * t1, pe0 = X * t0;
    P[4 * g + 3] = X - pe2; P[4 * g + 2] = pe2 - pe1; P[4 * g + 1] = pe1 - pe0; P[4 * g] = pe0 - XG;
    Y = Y2;
  }
}
template <bool DIAG>
__device__ __forceinline__ void sb_tile(St& s, const ALAS char* kp, int kx, const ALAS char* vp, const bf16x8* qr, int qrel, int hi) {
  const bool lowrows = DIAG && (qrel < 32);
  f32x16 p0, p1; bf16x8 kf0[4], kf1[4]; const f32x16 z = {};
  k_frags(kf0, kp, kx);
  if (!lowrows) { k_frags(kf1, kp + 4096, kx); qk_half(p1, kf1, qr, z); }
  qk_half(p0, kf0, qr, z);
  SCHED_FENCE();
  VF vf; float Y = s.R;
  if (!lowrows) {
    v_frags(vf, vp + 4096);
    if (DIAG) sb_half<true>(p1, Y, qrel - 32, hi); else sb_half<false>(p1, Y, 0, hi);
    SCHED_FENCE();
    pv_half(s, vf, p1);
    SCHED_FENCE();
    v_frags(vf, vp);
    sb_half<false>(p0, Y, 0, hi);
  } else {
    v_frags(vf, vp);
    sb_half<true>(p0, Y, qrel, hi);
  }
  SCHED_FENCE();
  pv_half(s, vf, p0);
  s.R = Y;
}

template <int MODE>
__device__ __forceinline__ void bh_item(int rowbase, int qb_hi, int qb_lo, const bf16* Q, const bf16* K, const bf16* V, const bf16* Z, bf16* O, ALAS char* shm3, int tid_in) {
  const int tid = tid_in, lane = tid & 63, r32 = lane & 31, hi = lane >> 5; const int wid = __builtin_amdgcn_readfirstlane(tid >> 6);
  const int pr = wid >> 1, w2 = (wid ^ (wid >> 2)) & 1, wrow = 64 * pr + 32 * w2;
  const bf16* Kh = K + (size_t)rowbase * PITCH; const bf16* Vh = V + (size_t)rowbase * PITCH;
  const unsigned lds0 = (unsigned)(uintptr_t)shm3;
  ALAS float* wsf = (ALAS float*)(shm3 + L_WSF) + wid * 64;
  const ALAS float* cum = (const ALAS float*)(shm3 + L_CUM);
  ALAS unsigned* misc = (ALAS unsigned*)(shm3 + L_MISC);
  const bf16* ksrc = Kh + (size_t)(8 * wid + (lane >> 3)) * PITCH + (((lane & 7) ^ (((8 * wid + (lane >> 3)) >> 1) & 7)) * 8);
  const bf16* vsrc = Vh + (size_t)(8 * wid + ((lane & 31) >> 2)) * PITCH + (lane >> 5) * 32 + (lane & 3) * 8;
  const unsigned kdst = lds0 + wid * 1024, vdst = lds0 + 8192 + wid * 1024;
#define DMA_KV(jt) do { const int sl_ = (jt) % NSLOT; glds16(ksrc + (size_t)(jt) * KVB * PITCH, (unsigned)__builtin_amdgcn_readfirstlane(kdst + sl_ * SLOTB)); \
                        glds16(vsrc + (size_t)(jt) * KVB * PITCH, (unsigned)__builtin_amdgcn_readfirstlane(vdst + sl_ * SLOTB)); } while (0)
#define ISSUE_UNIT(qb_, QR, NDMA) do { const int nb0_ = 4 * (qb_); const int tlo_ = (lo >= nb0_ - 1) ? (nb0_ > 0 ? nb0_ - 1 : 0) : nb0_ - 2; NDMA = 0; \
    for (int j_ = nb0_ + 3; j_ >= tlo_; --j_) if (j_ < lo || j_ > lo + 5) { DMA_KV(j_); ++NDMA; } \
    lo = tlo_; \
    const bf16* Qw_ = Q + (size_t)(rowbase + (qb_) * QB + wrow) * PITCH; \
    _Pragma("unroll") for (int d0 = 0; d0 < 4; ++d0) QR[d0] = *(const bf16x8*)(Qw_ + (size_t)r32 * PITCH + d0 * 16 + hi * 8); } while (0)
#define LOAD_Z(qb_, ZZ) do { const bf16* Zw_ = Z + (size_t)(rowbase + (qb_) * QB + wrow) * PITCH; \
    _Pragma("unroll") for (int i_ = 0; i_ < 4; ++i_) ZZ[i_] = *(const u32x4*)(Zw_ + (size_t)(i_ * 8 + (lane >> 3)) * PITCH + (lane & 7) * 8); } while (0)
  const ALAS char* kp0 = shm3 + r32 * 128;
  const int kx = ((hi ^ (r32 >> 1)) & 7) << 4;
  const ALAS char* vp0 = shm3 + 8192 + ((lane >> 4) & 1) * 32 + (lane & 3) * 8 + (4 * hi + ((lane & 15) >> 2)) * 64;
  const int qrel = w2 * 32 + r32;
  bf16x8 qr[4]; int lo = 1 << 20, ndma = 0;
  ISSUE_UNIT(qb_hi, qr, ndma);
  for (int qb = qb_hi; qb >= qb_lo; --qb) {
    const int q0 = qb * QB, jb0 = 4 * qb, jd = jb0 + pr;
    AWAIT_BAR(0);
    {
      const bf16* Zw_ = Z + (size_t)(rowbase + q0 + wrow) * PITCH + (size_t)lane * 8;
      const unsigned zdst = (unsigned)__builtin_amdgcn_readfirstlane(lds0 + L_OST + wid * 4096);
#pragma unroll
      for (int i_ = 0; i_ < 4; ++i_) glds16(Zw_ + (size_t)i_ * 8 * PITCH, zdst + i_ * 1024);
    }
    St s; s.o0 = f32x16{}; s.o1 = f32x16{}; s.mhat = 0.f; s.l = 0.f; s.R = 1.0f;
    float cq2 = 0.f, qkb = 0.f;
    if (MODE == 0) {
      cq2 = cum[q0 + wrow + r32];
      float n2l = 0.f, n2h = 0.f;
#pragma unroll
      for (int d0 = 0; d0 < 4; ++d0)
#pragma unroll
        for (int e = 0; e < 8; ++e) { const float v = __uint_as_float(((unsigned)(unsigned short)qr[d0][e]) << 16); if (d0 < 2) n2l += v * v; else n2h += v * v; }
      qkb = (sqrtf(swap_sum(n2l)) * __uint_as_float(misc[1]) + sqrtf(swap_sum(n2h)) * __uint_as_float(misc[2])) * 1.0001f;
    }
    bool done = false;
    const int NSTEP = jb0 + 4;
    for (int i = 0; i < NSTEP; ++i) {
      const int jt = jd - i, pre = jb0 - i - 2;
      const bool issued = (pre >= 0 && pre < lo);
      if (issued) { DMA_KV(pre); lo = pre; }
      if (!done) {
        if (jt < 0) done = true;
        else {
          const int sl = jt % NSLOT;
          const ALAS char* kp = kp0 + sl * SLOTB; const ALAS char* vp = vp0 + sl * SLOTB;
          if (MODE == 0) {
            if (i == 0) fox_tile<true>(s, kp, kx, vp, qr, cum + 64 * jt, cq2, qrel, hi, r32, wsf);
            else fox_tile<false>(s, kp, kx, vp, qr, cum + 64 * jt, cq2, qrel, hi, r32, wsf);
            if (jt == 0) done = true;
            else { const float cprev = cum[64 * jt - 1]; done = __all((11.0f + qkb + cq2 - cprev - s.mhat) < -32.0f) != 0; }
          } else {
            if (i == 0) sb_tile<true>(s, kp, kx, vp, qr, qrel, hi);
            else sb_tile<false>(s, kp, kx, vp, qr, qrel, hi);
            if (jt == 0) done = true;
            else done = __all(s.R < 0x1p-40f) != 0;
          }
        }
      }
      if (lane == 0) misc[8 + 8 * (i & 1) + wid] = done ? 1u : 0u;
      if (issued) AWAIT_BAR(2); else AWAIT_BAR(0);
      const u32x4 f0 = *(const ALAS u32x4*)(misc + 8 + 8 * (i & 1)), f1 = *(const ALAS u32x4*)(misc + 12 + 8 * (i & 1));
      const unsigned alld = (f0[0] & f0[1] & f0[2] & f0[3]) & (f1[0] & f1[1] & f1[2] & f1[3]);
      if (__builtin_amdgcn_readfirstlane(alld)) break;
    }
    if (qb > qb_lo) ISSUE_UNIT(qb - 1, qr, ndma);
    if (MODE == 0) {
      const float lt = swap_sum(s.l); const float inv = __builtin_amdgcn_rcpf(lt);
      if (hi == 0) wsf[r32] = inv;
      asm volatile("s_waitcnt lgkmcnt(0)" ::: "memory");
#pragma unroll
      for (int r = 0; r < 16; ++r) { const float f = wsf[crow(r, hi)]; s.o0[r] *= f; s.o1[r] *= f; }
    }
    ALAS float* stg = (ALAS float*)(shm3 + L_OST + wid * 4096);
    u32x4 zz[4];
#pragma unroll
    for (int i_ = 0; i_ < 4; ++i_) zz[i_] = *(const ALAS u32x4*)(shm3 + L_OST + wid * 4096 + i_ * 1024 + lane * 16);
    asm volatile("s_waitcnt lgkmcnt(0)" ::: "memory");
    bf16* Ow = O + (size_t)(rowbase + q0 + wrow) * PITCH;
#pragma unroll
    for (int ps = 0; ps < 2; ++ps) {
#pragma unroll
      for (int r8 = 0; r8 < 8; ++r8) { const int r = ps * 8 + r8; const int orow = crow(r8, hi); stg[orow * 64 + r32] = s.o0[r]; stg[orow * 64 + 32 + r32] = s.o1[r]; }
      asm volatile("s_waitcnt lgkmcnt(0)" ::: "memory");
#pragma unroll
      for (int i2 = 0; i2 < 2; ++i2) {
        const int row = i2 * 8 + (lane >> 3), ch = lane & 7, i = ps * 2 + i2;
        const f32x4 a = *(const ALAS f32x4*)(stg + row * 64 + ch * 8), b = *(const ALAS f32x4*)(stg + row * 64 + ch * 8 + 4);
        float ov[8] = {a[0], a[1], a[2], a[3], b[0], b[1], b[2], b[3]};
        unsigned w[4];
#pragma unroll
        for (int e = 0; e < 4; ++e) {
          const float z0 = __uint_as_float(zz[i][e] << 16), z1 = __uint_as_float(zz[i][e] & 0xffff0000u);
          const float g0 = z0 * __builtin_amdgcn_rcpf(1.0f + __builtin_amdgcn_exp2f(-1.4426950408889634f * z0));
          const float g1 = z1 * __builtin_amdgcn_rcpf(1.0f + __builtin_amdgcn_exp2f(-1.4426950408889634f * z1));
          w[e] = cvtpk(ov[2 * e] * g0, ov[2 * e + 1] * g1);
        }
        *(u32x4*)(Ow + (size_t)(ps * 16 + row) * PITCH + ch * 8) = (u32x4){w[0], w[1], w[2], w[3]};
      }
      asm volatile("s_waitcnt lgkmcnt(0)" ::: "memory");
    }
  }
  asm volatile("s_waitcnt vmcnt(0)" ::: "memory");
#undef DMA_KV
#undef ISSUE_UNIT
#undef LOAD_Z
}
}
constexpr int NWAVES = 8;
constexpr int DM = 1024, NB = 32, SEQ = 2048, MTOK = NB * SEQ, DI = 2048, NH = 32;
constexpr int NCHUNK = 2, CH = MTOK / NCHUNK, CHB = NB / NCHUNK;
constexpr int NIN0 = 8448, NIN0_REAL = 8224, NIN1 = 8192;
constexpr float NORM_EPS = 1e-6f;
constexpr size_t MiB = 1u << 20;
constexpr size_t WS_WIN0 = 0, WS_WIN1 = 17 * MiB, WS_WOUT0 = 33 * MiB, WS_WOUT1 = 37 * MiB, WS_MOD = 41 * MiB, WS_LOGF = 42 * MiB, WS_H = 46 * MiB, WS_Q = 110 * MiB;
constexpr size_t WS_CNT = WS_MOD + 0xE0000;
constexpr size_t WS_KMX = WS_MOD + 0xE8000;
constexpr size_t WS_BAR = WS_MOD + 0xE1000;
constexpr int LDS_BARST = 147200;
constexpr size_t QKVZ_STRIDE = (size_t)CH * DI;
constexpr size_t WS_X1B = WS_Q + 4 * QKVZ_STRIDE * 2, WS_X2B = WS_X1B + (size_t)MTOK * DM * 2;
constexpr size_t WS_END = WS_X2B + (size_t)MTOK * DM * 2;
static_assert((size_t)NIN0 * DM * 2 <= WS_WIN1 && (size_t)CH * 32 * 4 <= WS_H - WS_LOGF && (size_t)CH * DM * 2 <= WS_Q - WS_H, "d_ws map");
constexpr int RING_BYTES = 131072, LDS_BYTES = 147456;
static_assert(att::L_END <= LDS_BYTES, "attention LDS map");
#define GAS __attribute__((address_space(1)))
#define LAS __attribute__((address_space(3)))
typedef unsigned short bf16raw;
typedef unsigned v4u __attribute__((ext_vector_type(4)));
typedef float f32x4 __attribute__((ext_vector_type(4)));
#define LDS_WAIT() asm volatile("s_waitcnt lgkmcnt(0)" ::: "memory")
__device__ __forceinline__ unsigned f2bf(float f) { unsigned u = __builtin_bit_cast(unsigned, f); return (u + 0x7fffu + ((u >> 16) & 1u)) >> 16; }
__device__ __forceinline__ unsigned pk2(float lo, float hi) { return f2bf(lo) | (f2bf(hi) << 16); }
__device__ __forceinline__ float wave_sum(float v) {
#pragma unroll
    for (int o = 1; o < 64; o <<= 1) v += __shfl_xor(v, o);
    return v;
}
struct Params { const float *x, *c, *fng, *fwada, *fbada, *fwin, *fbf, *fwout, *sng, *swada, *sbada, *swin, *swout, *fing; float* out; unsigned char* ws; };

__device__ __forceinline__ void transpose_item(const float* W, int K, int N, bf16raw* WT, LAS float* scr, int item, int lane) {
    const int nblk = N / 32, kb = item / nblk, nb = item % nblk, k0 = 64 * kb, n0 = 32 * nb;
#pragma unroll 8
    for (int i = 0; i < 32; ++i) { const int kk = 2 * i + (lane >> 5); scr[kk * 33 + (lane & 31)] = W[(size_t)(k0 + kk) * N + n0 + (lane & 31)]; }
    LDS_WAIT(); asm volatile("" ::: "memory");
    const int c = lane & 7;
#pragma unroll
    for (int j = 0; j < 4; ++j) { const int n = (lane >> 3) + 8 * j; const LAS float* s = scr + (8 * c) * 33 + n;
        v4u o; o.x = pk2(s[0 * 33], s[1 * 33]); o.y = pk2(s[2 * 33], s[3 * 33]); o.z = pk2(s[4 * 33], s[5 * 33]); o.w = pk2(s[6 * 33], s[7 * 33]);
        *(v4u*)(WT + (size_t)(n0 + n) * K + k0 + 8 * c) = o; }
    LDS_WAIT(); asm volatile("" ::: "memory");
}

__device__ __forceinline__ void ada_item(const float* c, const float* W, const float* bias, float* mod, int cb, LAS unsigned char* lds, int tid) {
    const int lane = tid & 63, wave = tid >> 6;
    LAS float* sc = (LAS float*)lds + wave * 4096;
    for (int i = lane; i < 4096; i += 64) { const int b = i >> 7, kk = i & 127; const float v = c[b * DM + wave * 128 + kk]; sc[i] = v / (1.0f + __expf(-v)); }
    LDS_WAIT(); asm volatile("" ::: "memory");
    float acc[32];
#pragma unroll
    for (int b = 0; b < 32; ++b) acc[b] = 0.f;
    const float* Wp = W + (size_t)(wave * 128) * 3072 + cb * 64 + lane;
    for (int kk = 0; kk < 128; kk += 4) {
        const float w0 = Wp[(size_t)(kk + 0) * 3072], w1 = Wp[(size_t)(kk + 1) * 3072], w2 = Wp[(size_t)(kk + 2) * 3072], w3 = Wp[(size_t)(kk + 3) * 3072];
#pragma unroll
        for (int b = 0; b < 32; ++b) { const f32x4 s4 = *(const LAS f32x4*)(sc + b * 128 + kk); acc[b] += s4[0] * w0 + s4[1] * w1 + s4[2] * w2 + s4[3] * w3; }
    }
    __syncthreads();
    LAS float* red = (LAS float*)lds;
#pragma unroll
    for (int b = 0; b < 32; ++b) red[(wave * 32 + b) * 64 + lane] = acc[b];
    __syncthreads();
    for (int o = tid; o < 2048; o += 512) { const int b = o >> 6, col = o & 63; float sacc = 0.f;
#pragma unroll
        for (int w = 0; w < 8; ++w) sacc += red[(w * 32 + b) * 64 + col];
        mod[(size_t)b * 3072 + cb * 64 + col] = sacc + bias[cb * 64 + col]; }
    __syncthreads();
}

template <bool BF> __device__ __forceinline__ f32x4 ld_row4(const void* src, size_t row, int lane, int j) {
    if (BF) { typedef unsigned u32x2_ __attribute__((ext_vector_type(2))); const u32x2_ w = *((const u32x2_*)((const bf16raw*)src + row * DM) + lane + 64 * j);
        return (f32x4){__uint_as_float(w.x << 16), __uint_as_float(w.x & 0xffff0000u), __uint_as_float(w.y << 16), __uint_as_float(w.y & 0xffff0000u)}; }
    return *((const f32x4*)((const float*)src + row * DM) + lane + 64 * j);
}
template <bool BF>
__device__ __forceinline__ void norm_rows(const void* src, const float* g, const float* mod, bf16raw* H, int grow0, int lrow0, int nrows, int lane) {
    const int b = grow0 >> 11;
    f32x4 mul[4], add[4];
#pragma unroll
    for (int j = 0; j < 4; ++j) { const f32x4 gg = *(const f32x4*)(g + 4 * lane + 256 * j), sc = *(const f32x4*)(mod + (size_t)b * 3072 + 1024 + 4 * lane + 256 * j);
        mul[j] = gg * (sc + 1.0f); add[j] = *(const f32x4*)(mod + (size_t)b * 3072 + 4 * lane + 256 * j); }
    for (int r = 0; r < nrows; r += 4) {
        f32x4 v[4][4]; float s[4];
#pragma unroll
        for (int q = 0; q < 4; ++q) {
#pragma unroll
            for (int j = 0; j < 4; ++j) v[q][j] = ld_row4<BF>(src, (size_t)(grow0 + r + q), lane, j); }
#pragma unroll
        for (int q = 0; q < 4; ++q) { s[q] = 0.f;
#pragma unroll
            for (int j = 0; j < 4; ++j) s[q] += (v[q][j].x * v[q][j].x + v[q][j].y * v[q][j].y) + (v[q][j].z * v[q][j].z + v[q][j].w * v[q][j].w); }
#pragma unroll
        for (int o = 1; o < 64; o <<= 1) {
#pragma unroll
            for (int q = 0; q < 4; ++q) s[q] += __shfl_xor(s[q], o); }
#pragma unroll
        for (int q = 0; q < 4; ++q) { const float rstd = 1.0f / sqrtf(s[q] * (1.0f / DM) + NORM_EPS);
            unsigned long long* o8 = (unsigned long long*)(H + (size_t)(lrow0 + r + q) * DM) + lane;
#pragma unroll
            for (int j = 0; j < 4; ++j) { const f32x4 y = v[q][j] * rstd * mul[j] + add[j];
                o8[64 * j] = (unsigned long long)pk2(y.x, y.y) | ((unsigned long long)pk2(y.z, y.w) << 32); } }
    }
}
__device__ __forceinline__ void final_norm_rows(const bf16raw* x2, float* out, const float* g, int row0, int nrows, int lane) {
    f32x4 mul[4];
#pragma unroll
    for (int j = 0; j < 4; ++j) mul[j] = *(const f32x4*)(g + 4 * lane + 256 * j);
    for (int r = 0; r < nrows; r += 4) {
        f32x4 v[4][4]; float s[4];
#pragma unroll
        for (int q = 0; q < 4; ++q) {
#pragma unroll
            for (int j = 0; j < 4; ++j) v[q][j] = ld_row4<true>(x2, (size_t)(row0 + r + q), lane, j); }
#pragma unroll
        for (int q = 0; q < 4; ++q) { s[q] = 0.f;
#pragma unroll
            for (int j = 0; j < 4; ++j) s[q] += (v[q][j].x * v[q][j].x + v[q][j].y * v[q][j].y) + (v[q][j].z * v[q][j].z + v[q][j].w * v[q][j].w); }
#pragma unroll
        for (int o = 1; o < 64; o <<= 1) {
#pragma unroll
            for (int q = 0; q < 4; ++q) s[q] += __shfl_xor(s[q], o); }
#pragma unroll
        for (int q = 0; q < 4; ++q) { const float rstd = 1.0f / sqrtf(s[q] * (1.0f / DM) + NORM_EPS);
            f32x4* xw = (f32x4*)(out + (size_t)(row0 + r + q) * DM) + lane;
#pragma unroll
            for (int j = 0; j < 4; ++j) xw[64 * j] = v[q][j] * rstd * mul[j]; }
    }
}

__device__ __forceinline__ void fox_prep(const float* lf, const unsigned* kmx, int tok0, int h, LAS unsigned char* lds, int tid) {
    LAS float* cum = (LAS float*)(lds + att::L_CUM); LAS float* tot = (LAS float*)(lds + att::L_WSF); LAS unsigned* misc = (LAS unsigned*)(lds + att::L_MISC);
    __syncthreads();
    const int lane = tid & 63, wave = tid >> 6;
    const float* p = lf + (size_t)(tok0 + 4 * tid) * 32 + h;
    float a0 = p[0], a1 = p[32], a2 = p[64], a3 = p[96];
    a1 += a0; a2 += a1; a3 += a2;
    float inc = a3;
#pragma unroll
    for (int o = 1; o < 64; o <<= 1) { const float t = __int_as_float(__builtin_amdgcn_ds_bpermute((lane >= o ? lane - o : lane) << 2, __float_as_int(inc))); if (lane >= o) inc += t; }
    if (lane == 63) tot[wave] = inc;
    __syncthreads();
    float base = inc - a3;
    for (int w = 0; w < wave; ++w) base += tot[w];
    *(LAS f32x4*)(cum + 4 * tid) = (f32x4){a0 + base, a1 + base, a2 + base, a3 + base};
    if (tid < 2) misc[1 + tid] = __float_as_uint(sqrtf(__uint_as_float(__hip_atomic_load(kmx + tid, __ATOMIC_RELAXED, __HIP_MEMORY_SCOPE_AGENT))));
    __syncthreads();
}

#define XB_TMO      128
#define XB_XCNT(j)  (256  + 64 * (j))
#define XB_XSUB(j)  (1280 + 64 * (j))
#define XB_XGEN(j)  (2304 + 64 * (j))
#define XB_TOP      3328
#define XB_TOPGEN   3392
#define XCD_BAR_WORDS 3456
#define XB_SPIN_CAP (1u << 18)

__device__ __forceinline__ unsigned xb_ld(unsigned* p)              { return __hip_atomic_load(p, __ATOMIC_RELAXED, __HIP_MEMORY_SCOPE_AGENT); }
__device__ __forceinline__ unsigned xb_add(unsigned* p, unsigned v) { return __hip_atomic_fetch_add(p, v, __ATOMIC_RELAXED, __HIP_MEMORY_SCOPE_AGENT); }
__device__ __forceinline__ unsigned xb_xcc_id() { return (unsigned)__builtin_amdgcn_s_getreg((3 << 11) | 20) & 0xFu; }
#define XB_SPIN(cond, bar) do { unsigned _sp = 0; while (cond) { __builtin_amdgcn_s_sleep(1); \
    if ((++_sp & 255u) == 0u) { if (xb_ld(&(bar)[XB_TMO])) break; if (_sp > XB_SPIN_CAP) { atomicAdd(&(bar)[XB_TMO], 1u); break; } } } } while (0)

struct XcdBarrier {
    unsigned* bar; unsigned x;
    volatile LAS unsigned* st;
};

__device__ __forceinline__ XcdBarrier xcd_barrier_post(unsigned* bar, volatile LAS unsigned* st) {
    XcdBarrier b; b.bar = bar; b.x = xb_xcc_id(); b.st = st;
    if (threadIdx.x == 0) (void)xb_add(&bar[XB_XCNT(b.x)], 1u);
    return b;
}
__device__ __forceinline__ void xcd_barrier_complete(unsigned* bar, unsigned x, unsigned& nloc, unsigned& nx) {
    const unsigned G = gridDim.x * gridDim.y * gridDim.z;
    unsigned sum, cnt, mine, sp = 0u;
    for (;;) {
        sum = 0u; cnt = 0u; mine = 0u;
#pragma unroll
        for (unsigned j = 0; j < 16; ++j) { const unsigned c = xb_ld(&bar[XB_XCNT(j)]); sum += c; cnt += (c > 0u) ? 1u : 0u; mine = (j == x) ? c : mine; }
        if (sum == G) break;
        __builtin_amdgcn_s_sleep(1);
        if ((++sp & 255u) == 0u) { if (xb_ld(&bar[XB_TMO])) break; if (sp > XB_SPIN_CAP) { atomicAdd(&bar[XB_TMO], 1u); break; } }
    }
    nloc = mine > 0u ? mine : 1u; nx = cnt > 0u ? cnt : 1u;
}

__device__ __forceinline__ void xcd_barrier(const XcdBarrier& b) {
    asm volatile("s_waitcnt vmcnt(0)" ::: "memory");
    __syncthreads();
    if (threadIdx.x == 0) {
        unsigned* bar = b.bar;
        __builtin_amdgcn_s_waitcnt(0);
        unsigned nloc = b.st[0], nx = b.st[1];
        if (nloc == 0u) { xcd_barrier_complete(bar, b.x, nloc, nx); b.st[0] = nloc; b.st[1] = nx; }
        const unsigned old = xb_add(&bar[XB_XSUB(b.x)], 1u);
        const unsigned gen = old / nloc;
        if (old + 1u == (gen + 1u) * nloc) {
            __builtin_amdgcn_fence(__ATOMIC_RELEASE, "agent");
            asm volatile("s_waitcnt vmcnt(0)" ::: "memory");
            const unsigned og = xb_add(&bar[XB_TOP], 1u);
            const unsigned tg = og / nx;
            if (og + 1u == (tg + 1u) * nx) xb_add(&bar[XB_TOPGEN], 1u);
            else XB_SPIN(xb_ld(&bar[XB_TOPGEN]) == tg, bar);
            __builtin_amdgcn_fence(__ATOMIC_ACQUIRE, "agent");
            xb_add(&bar[XB_XGEN(b.x)], 1u);
            asm volatile("s_waitcnt vmcnt(0)" ::: "memory");
        } else {
            XB_SPIN(xb_ld(&bar[XB_XGEN(b.x)]) == gen, bar);
            __builtin_amdgcn_fence(__ATOMIC_ACQUIRE, "agent");
            asm volatile("s_waitcnt vmcnt(0)" ::: "memory");
        }
    }
    __syncthreads();
}

__device__ __forceinline__ void forget_task(const bf16raw* H, const bf16raw* Wf, const float* bfb, float* lf, int row0, int lane) {
    typedef short bf16x8_ __attribute__((ext_vector_type(8))); typedef float f32x16_ __attribute__((ext_vector_type(16)));
    const int r = lane & 31, hi = lane >> 5;
    const bf16x8_* ap = (const bf16x8_*)(H + (size_t)(row0 + r) * DM + hi * 8);
    const bf16x8_* bp = (const bf16x8_*)(Wf + (size_t)r * DM + hi * 8);
    f32x16_ acc = {};
#pragma unroll 8
    for (int ks = 0; ks < DM / 16; ++ks) acc = __builtin_amdgcn_mfma_f32_32x32x16_bf16(ap[2 * ks], bp[2 * ks], acc, 0, 0, 0);
    const float bias = bfb[r];
#pragma unroll
    for (int q = 0; q < 16; ++q) { const int row = row0 + (q & 3) + 8 * (q >> 2) + 4 * hi; const float xx = acc[q] + bias;
        lf[(size_t)row * 32 + r] = (fminf(xx, 0.f) - log1pf(__expf(-fabsf(xx)))) * 1.4426950408889634f; }
}

__device__ __forceinline__ int fresh_tid_(int wave_s) { int t = (wave_s << 6) | (int)__builtin_amdgcn_mbcnt_hi(~0u, __builtin_amdgcn_mbcnt_lo(~0u, 0u)); asm volatile("" : "+v"(t)); return t; }
#define fresh_tid() fresh_tid_(wave_s)
#define CAS __attribute__((address_space(4)))
__device__ __forceinline__ const CAS Params* launder(const CAS Params* q) { asm volatile("" : "+s"(q)); return q; }
#define PP (launder(kp0))
#ifndef PROBE_MASK
#define PROBE_MASK 0u
#endif
#if PROBE_MASK
#define STAMP(k) do { const unsigned long long t_ = __builtin_amdgcn_s_memrealtime(); if ((PROBE_MASK >> (k)) & 1u) pr_acc += t_ - pr_prev; pr_prev = t_; } while (0)
#else
#define STAMP(k) do { } while (0)
#endif
__global__ void __launch_bounds__(NWAVES * 64) mega_fwd(Params p_kernarg) {
    const CAS Params* const kp0 = (const CAS Params*)__builtin_amdgcn_kernarg_segment_ptr();
    extern __shared__ __attribute__((aligned(16))) unsigned char lds_raw[];
    cg::grid_group grid = cg::this_grid();
#if PROBE_MASK
    unsigned long long pr_prev = __builtin_amdgcn_s_memrealtime(), pr_acc = 0ull;
#endif
    LAS unsigned char* lds = (LAS unsigned char*)lds_raw;
    const int wave_s = __builtin_amdgcn_readfirstlane(threadIdx.x >> 6);
    if (threadIdx.x < 2) ((volatile LAS unsigned*)(lds + LDS_BARST))[threadIdx.x] = 0u;
    __syncthreads();
    XcdBarrier bar = xcd_barrier_post((unsigned*)(PP->ws + WS_BAR), (volatile LAS unsigned*)(lds + LDS_BARST));
    const int G = gridDim.x, bx = blockIdx.x; const int vcu = (G % 8 == 0) ? (bx % 8) * (G / 8) + bx / 8 : bx;
#define WIN_T(l) ((bf16raw*)(PP->ws + ((l) ? WS_WIN1 : WS_WIN0)))
#define WOUT_T(l) ((bf16raw*)(PP->ws + ((l) ? WS_WOUT1 : WS_WOUT0)))
#define MOD_ ((float*)(PP->ws + WS_MOD))
#define LF_ ((float*)(PP->ws + WS_LOGF))
#define H_ ((bf16raw*)(PP->ws + WS_H))
#define QB_ ((bf16raw*)(PP->ws + WS_Q))

    {
        const int tid = fresh_tid(), lane = tid & 63, wave = __builtin_amdgcn_readfirstlane(tid >> 6);
        LAS float* scr = (LAS float*)(lds + wave * 16384);
        const int NADA = (G >= 96) ? 96 : 0;
        const int NGW = (G - NADA) * NWAVES + NADA * 4;
        const int gw = (bx < NADA) ? ((wave < 4) ? bx * 4 + wave : NGW) : NADA * 4 + (bx - NADA) * NWAVES + wave;
        constexpr int I_IN0 = 16 * (NIN0_REAL / 32), I_IN1 = 16 * (NIN1 / 32), I_OUT = 32 * 32;
        constexpr int NITEMS = I_IN0 + I_OUT;
        for (int it = (gw < NGW ? gw : NITEMS); it < NITEMS; it += NGW) {
            int r = it;
            if (r < I_IN0) { transpose_item(PP->fwin, DM, NIN0_REAL, WIN_T(0), scr, r, lane); continue; } r -= I_IN0;
            transpose_item(PP->fwout, DI, DM, WOUT_T(0), scr, r, lane);
        }
        { v4u* z = (v4u*)(WIN_T(0) + (size_t)NIN0_REAL * DM); const int n16 = (NIN0 - NIN0_REAL) * DM * 2 / 16;
          for (int i = bx * 512 + tid; i < n16; i += G * 512) z[i] = (v4u){0u, 0u, 0u, 0u}; }
        if (bx == 0 && tid < 6) ((unsigned*)(PP->ws + WS_CNT))[16 * tid] = 0u;
        if (bx == 0) {
                       unsigned* kw = (unsigned*)(PP->ws + WS_KMX); for (int i = tid; i < NCHUNK * CHB * NH * 2; i += 512) kw[i] = 0u; }
        __syncthreads();
        for (int it = bx; it < 96; it += G) { const int l = it / 48, cb = it % 48;
            ada_item(PP->c, l ? PP->swada : PP->fwada, l ? PP->sbada : PP->fbada, MOD_ + (size_t)l * NB * 3072, cb, lds, tid); }
    }
    if (PP->ws == nullptr) grid.sync();
    xcd_barrier(bar); STAMP(0);
    const int rows_per_wave = CH / (G * NWAVES);
#define NORM_PHASE(l, ch) do { const int tid = fresh_tid(), lane = tid & 63, wave = __builtin_amdgcn_readfirstlane(tid >> 6); const int lr0 = (vcu * NWAVES + wave) * rows_per_wave; \
        if (l) norm_rows<true>((const void*)(PP->ws + WS_X1B), PP->sng, MOD_ + (size_t)NB * 3072, H_, (ch) * CH + lr0, lr0, rows_per_wave, lane); \
        else norm_rows<false>((const void*)PP->x, PP->fng, MOD_, H_, (ch) * CH + lr0, lr0, rows_per_wave, lane); } while (0)
    NORM_PHASE(0, 0);
    xcd_barrier(bar); STAMP(1);
    auto layer_chunk = [&](auto LC, auto CC) __attribute__((always_inline)) {
        constexpr int l = decltype(LC)::value, ch = decltype(CC)::value;
            {
                if (l == 0) { const int tid = fresh_tid(), lane = tid & 63, wave = __builtin_amdgcn_readfirstlane(tid >> 6);
                    for (int task = vcu * NWAVES + wave; task < CH / 32; task += G * NWAVES) forget_task(H_, WIN_T(0) + (size_t)NIN1 * DM, PP->fbf, LF_, task * 32, lane); }
                pg8::Gemm g{H_, WIN_T(l), CH, NIN1, DM}; pg8::StaticOrder S; S.init(CH, NIN1, G, bx);
                pg8::EpiProj E{QB_, QKVZ_STRIDE, att::C2, LF_, PP->fbf, l ? (unsigned*)nullptr : (unsigned*)(PP->ws + WS_KMX) + ch * CHB * NH * 2};
                pg8::gemm_phase<pg8::EpiProj, pg8::StaticOrder, true, true>(lds, g, S, E, fresh_tid());
            }
            xcd_barrier(bar); STAMP(2 + 3 * (l * NCHUNK + ch));
            {
                const att::bf16* Qp = (const att::bf16*)QB_; const att::bf16* Kp = Qp + QKVZ_STRIDE; const att::bf16* Vp = Kp + QKVZ_STRIDE; const att::bf16* Zp = Vp + QKVZ_STRIDE;
                LAS unsigned* misc = (LAS unsigned*)(lds + att::L_MISC); const int tid = fresh_tid();
                if (tid < 32) { unsigned rank = tid;
                    if (l == 0) { const float* bfp = PP->fbf; const float mine = bfp[tid]; rank = 0; for (int j = 0; j < 32; ++j) { const float o = bfp[j]; rank += (o > mine || (o == mine && j < tid)) ? 1u : 0u; } }
                    misc[32 + rank] = tid; }
                __syncthreads();
                unsigned* counter = (unsigned*)(PP->ws + WS_CNT) + 16 * (l * NCHUNK + ch);
                for (;;) {
                    if (tid == 0) misc[0] = atomicAdd(counter, 1u);
                    __syncthreads();
                    const int it = __builtin_amdgcn_readfirstlane(misc[0]);
                    if (it >= CHB * NH * 2) break;
                    const int it2 = it >> 1, qhi = (it & 1) ? 3 : att::NQB - 1, qlo = (it & 1) ? 0 : 4;
                    const int h = __builtin_amdgcn_readfirstlane(misc[32 + it2 / CHB]), tok0 = (it2 % CHB) * SEQ, rowbase = ((it2 % CHB) * NH + h) * SEQ;
                    if (l == 0) { fox_prep(LF_, (const unsigned*)(PP->ws + WS_KMX) + ((ch * CHB + it2 % CHB) * NH + h) * 2, tok0, h, lds, fresh_tid());
                        att::bh_item<0>(rowbase, qhi, qlo, Qp, Kp, Vp, Zp, (att::bf16*)QB_, (LAS char*)lds, fresh_tid()); }
                    else att::bh_item<1>(rowbase, qhi, qlo, Qp, Kp, Vp, Zp, (att::bf16*)QB_, (LAS char*)lds, fresh_tid());
                }
                asm volatile("s_waitcnt vmcnt(0) lgkmcnt(0)" ::: "memory"); __syncthreads();
                if (l == 0) {
                    constexpr int I_IN1 = 16 * (NIN1 / 32), I_OUT1 = 32 * 32, NB1 = (I_IN1 + I_OUT1) / 8, NBP = NB1 / NCHUNK;
                    unsigned* tq = (unsigned*)(PP->ws + WS_CNT) + 16 * (4 + ch);
                    const int t2 = fresh_tid(), lane2 = t2 & 63, wave2 = __builtin_amdgcn_readfirstlane(t2 >> 6);
                    LAS float* scr2 = (LAS float*)(lds + wave2 * 16384);
                    for (;;) {
                        if (t2 == 0) misc[0] = atomicAdd(tq, 1u);
                        __syncthreads();
                        const int bq = __builtin_amdgcn_readfirstlane(misc[0]);
                        __syncthreads();
                        if (bq >= NBP) break;
                        const int r = (ch * NBP + bq) * 8 + wave2;
                        if (r < I_IN1) transpose_item(PP->swin, DM, NIN1, WIN_T(1), scr2, r, lane2);
                        else transpose_item(PP->swout, DI, DM, WOUT_T(1), scr2, r - I_IN1, lane2);
                    }
                }
            }
            xcd_barrier(bar); STAMP(3 + 3 * (l * NCHUNK + ch));
            {
                pg8::Gemm g{QB_, WOUT_T(l), CH, DM, DI}; pg8::StaticOrder S; S.init(CH, DM, G, bx);
                pg8::EpiRes<(l != 0)> E{l ? (const void*)(PP->ws + WS_X1B) : (const void*)PP->x, (pg8::bf16_t*)(PP->ws + (l ? WS_X2B : WS_X1B)), MOD_ + (size_t)l * NB * 3072 + 2048, ch * CH};
                pg8::gemm_phase<pg8::EpiRes<(l != 0)>, pg8::StaticOrder, true, true, true>(lds, g, S, E, fresh_tid());
            }
            if (ch + 1 < NCHUNK) NORM_PHASE(l, ch + 1);
            else if (l == 0) NORM_PHASE(1, 0);
            xcd_barrier(bar); STAMP(4 + 3 * (l * NCHUNK + ch));
    };
    layer_chunk(std::integral_constant<int, 0>{}, std::integral_constant<int, 0>{});
    layer_chunk(std::integral_constant<int, 0>{}, std::integral_constant<int, 1>{});
    layer_chunk(std::integral_constant<int, 1>{}, std::integral_constant<int, 0>{});
    layer_chunk(std::integral_constant<int, 1>{}, std::integral_constant<int, 1>{});
    { const int tid = fresh_tid(), lane = tid & 63, wave = __builtin_amdgcn_readfirstlane(tid >> 6); const int rpw = MTOK / (G * NWAVES); final_norm_rows((const bf16raw*)(PP->ws + WS_X2B), PP->out, PP->fing, (vcu * NWAVES + wave) * rpw, rpw, lane); }
#if PROBE_MASK
    STAMP(14);
    if (bx == 0 && fresh_tid() == 0) { const unsigned long long t0_ = __builtin_amdgcn_s_memrealtime(); while (__builtin_amdgcn_s_memrealtime() - t0_ < pr_acc) __builtin_amdgcn_s_sleep(16); }
#endif
}

extern "C" void kernel_launch(void* const* d_in, const int* in_sizes, int n_in, void* d_out, int out_size, void* d_ws, size_t ws_size, hipStream_t stream) {
    static int grid = 0;
    if (grid == 0) {
        if (n_in != 14 || in_sizes[0] != MTOK * DM || out_size != MTOK * DM || ws_size < WS_END) { fprintf(stderr, "kernel_launch: unexpected shapes (n_in %d, in0 %d, out %d, ws %zu < %zu); nothing launched\n", n_in, n_in > 0 ? in_sizes[0] : -1, out_size, ws_size, (size_t)WS_END); grid = -1; return; }
        int dev = 0, cus = 0, per_cu = 0;
        if (hipGetDevice(&dev) != hipSuccess || hipDeviceGetAttribute(&cus, hipDeviceAttributeMultiprocessorCount, dev) != hipSuccess) { grid = -1; return; }
        if (hipFuncSetAttribute((const void*)mega_fwd, hipFuncAttributeMaxDynamicSharedMemorySize, LDS_BYTES) != hipSuccess) { fprintf(stderr, "kernel_launch: hipFuncSetAttribute failed\n"); grid = -1; return; }
        if (hipOccupancyMaxActiveBlocksPerMultiprocessor(&per_cu, (const void*)mega_fwd, NWAVES * 64, LDS_BYTES) != hipSuccess || per_cu < 1) { fprintf(stderr, "kernel_launch: occupancy query gave %d\n", per_cu); per_cu = 1; }
        (void)hipGetLastError();
        grid = cus * per_cu;
        if (CH % (grid * NWAVES) != 0 || grid % 8 != 0) { fprintf(stderr, "kernel_launch: grid %d does not divide the row split\n", grid); grid = -1; return; }
    }
    if (grid < 0) return;
    Params p{};
    p.x = (const float*)d_in[0]; p.c = (const float*)d_in[1]; p.fng = (const float*)d_in[2]; p.fwada = (const float*)d_in[3]; p.fbada = (const float*)d_in[4];
    p.fwin = (const float*)d_in[5]; p.fbf = (const float*)d_in[6]; p.fwout = (const float*)d_in[7]; p.sng = (const float*)d_in[8]; p.swada = (const float*)d_in[9];
    p.sbada = (const float*)d_in[10]; p.swin = (const float*)d_in[11]; p.swout = (const float*)d_in[12]; p.fing = (const float*)d_in[13];
    p.out = (float*)d_out; p.ws = (unsigned char*)d_ws;
    if (hipMemsetAsync((unsigned char*)d_ws + WS_BAR, 0, XCD_BAR_WORDS * 4, stream) != hipSuccess) { fprintf(stderr, "kernel_launch: hipMemsetAsync failed\n"); return; }
    void* args[] = {&p};
    hipError_t e = hipLaunchCooperativeKernel((const void*)mega_fwd, dim3(grid), dim3(NWAVES * 64), args, LDS_BYTES, stream);
    if (e != hipSuccess) fprintf(stderr, "kernel_launch: cooperative launch failed: %s (grid %d)\n", hipGetErrorString(e), grid);
}
```

```cpp
#include <hip/hip_runtime.h>
#include <hip/hip_cooperative_groups.h>
#include <hip/hip_bf16.h>
#include <cstdio>
#include <cstdint>
#include <cmath>
#include <type_traits>
namespace cg = cooperative_groups;
namespace pg8 {
#define PG8_LAS __attribute__((address_space(3)))
typedef unsigned short bf16_t;
typedef short bf16x8 __attribute__((ext_vector_type(8)));
typedef float f32x4 __attribute__((ext_vector_type(4)));
typedef unsigned u32x4 __attribute__((ext_vector_type(4)));
constexpr int BM = 256, BK = 64, HALF = 128, HTB = HALF * BK * 2  , STAGE_BYTES = 8 * HTB, NXCD = 8, WGM = 8;

__host__ __device__ __forceinline__ int lds_byte(int r, int c) { const int st = (r >> 4) * 2 + (c >> 5), rr = r & 15, cc = c & 31, ob = rr * 64 + cc * 2; return st * 1024 + (ob ^ (((ob >> 9) & 1) << 5)); }
__host__ __device__ __forceinline__ void stage_rc(int b, int& R, int& C) { const int st = b / 1024, sb = b % 1024, swz = sb ^ (((sb >> 9) & 1) << 5); R = (st >> 1) * 16 + swz / 64; C = (st & 1) * 32 + (swz % 64) / 2; }
__host__ __device__ __forceinline__ int perm32(int rho) { const int n = rho >> 4, i = rho & 15; return 8 * (i >> 2) + 4 * n + (i & 3); }

struct Unit { int pm, pn; };
struct Gemm { const bf16_t* A; const bf16_t* Bt; int M, N, K; };

struct StaticOrder {
    int nM, nN, nwg, G, c;
    __host__ __device__ void init(int M, int N, int G_, int c_) { nM = M / BM; nN = N / BM; nwg = nM * nN; G = G_; c = c_; }
    __host__ __device__ bool next(int i, Unit& u) const {
        const long L = (long)i * G + c; if (L >= nwg) return false;
        int wgid = (int)L; { const int q = nwg / NXCD, r = nwg % NXCD, xcd = wgid % NXCD, off = wgid / NXCD; wgid = (xcd < r ? xcd * (q + 1) : r * (q + 1) + (xcd - r) * q) + off; }
        const int nig = WGM * nN, gid = wgid / nig, fm = gid * WGM, gsz = (nM - fm) < WGM ? (nM - fm) : WGM;
        u.pm = fm + ((wgid % nig) % gsz); u.pn = (wgid % nig) / gsz; return true;
    }
    __device__ __forceinline__ void a_ready(const Unit&) const {}
    __device__ __forceinline__ void done(const Unit&) const {}
};

__device__ __forceinline__ unsigned cvt_pk_bf16(float lo, float hi) { unsigned r; asm volatile("v_cvt_pk_bf16_f32 %0, %1, %2" : "=v"(r) : "v"(lo), "v"(hi)); return r; }
typedef float f32x2 __attribute__((ext_vector_type(2)));
typedef float f32x2 __attribute__((ext_vector_type(2)));
struct EpiProj {
    static constexpr bool PERM = true, AFTER_DRAIN = false;
    bf16_t* O; size_t split_stride; float scale0; float* lf; const float* bf; unsigned* kmx;
    __device__ __forceinline__ void operator()(const f32x4 (&acc)[2][2][4][2], const Unit& u, int wr, int wc, int fr, int fq) const {
        const int t = u.pn >> 3;
        const int row0 = u.pm * BM + wr * 64 + fr;
        if (t < 4) {
            bf16_t* base = O + (size_t)t * split_stride; const float sc = (t == 0) ? scale0 : 1.f;
            const int bl = u.pm >> 3, s0 = (u.pm & 7) * BM + wr * 64 + fr, dcol = (wc & 1) * 32 + 8 * fq;
            float kss[2][8];
#pragma unroll
            for (int bj = 0; bj < 2; ++bj) { const int hd = (u.pn & 7) * 4 + bj * 2 + (wc >> 1); bf16_t* hp = base + ((size_t)(bl * 32 + hd) * 2048 + s0) * 64 + dcol;
#pragma unroll
                for (int ai = 0; ai < 2; ++ai)
#pragma unroll
                    for (int m = 0; m < 4; ++m) { f32x4 v0 = acc[ai][bj][m][0], v1 = acc[ai][bj][m][1]; if (t == 0) { v0 = v0 * sc; v1 = v1 * sc; }
                        u32x4 w; w.x = cvt_pk_bf16(v0[0], v0[1]); w.y = cvt_pk_bf16(v0[2], v0[3]); w.z = cvt_pk_bf16(v1[0], v1[1]); w.w = cvt_pk_bf16(v1[2], v1[3]);
                        *(u32x4*)(hp + (size_t)(ai * HALF + m * 16) * 64) = w;
                        if (t == 1 && kmx) { float ss = 0.f;
#pragma unroll
                            for (int e_ = 0; e_ < 4; ++e_) { const float lo_ = __uint_as_float(w[e_] << 16), hi_ = __uint_as_float(w[e_] & 0xffff0000u); ss += lo_ * lo_ + hi_ * hi_; }
                            kss[bj][ai * 4 + m] = ss; } } }
            if (t == 1 && kmx) {
#pragma unroll
                for (int bj = 0; bj < 2; ++bj) { float mx = 0.f;
#pragma unroll
                    for (int q = 0; q < 8; ++q) { float ss = kss[bj][q]; ss += __shfl_xor(ss, 16); ss += __shfl_xor(ss, 32); mx = fmaxf(mx, ss); }
#pragma unroll
                    for (int o = 1; o < 16; o <<= 1) mx = fmaxf(mx, __shfl_xor(mx, o));
                    if (fr == 0 && fq == 0) atomicMax(kmx + ((bl * 32 + (u.pn & 7) * 4 + bj * 2 + (wc >> 1)) * 2 + (wc & 1)), __float_as_uint(mx)); }
            }
        } else if (wc == 0) {
            f32x4 bv[2];
#pragma unroll
            for (int n = 0; n < 2; ++n) bv[n] = *(const f32x4*)(bf + 8 * fq + 4 * n);
#pragma unroll
            for (int ai = 0; ai < 2; ++ai)
#pragma unroll
                for (int m = 0; m < 4; ++m) { float* rowp = lf + (size_t)(row0 + ai * HALF + m * 16) * 32 + 8 * fq;
#pragma unroll
                    for (int n = 0; n < 2; ++n) { f32x4 v = acc[ai][0][m][n] + bv[n]; f32x4 o;
#pragma unroll
                        for (int e = 0; e < 4; ++e) { const float xx = v[e]; o[e] = (fminf(xx, 0.f) - log1pf(__expf(-fabsf(xx)))) * 1.4426950408889634f; }
                        *(f32x4*)(rowp + 4 * n) = o; } }
        }
    }
};
template <bool BASE_BF>
struct EpiRes {
    static constexpr bool PERM = true, AFTER_DRAIN = false;
    const void* base; bf16_t* outb; const float* gate; int row_off;
    __device__ __forceinline__ void operator()(const f32x4 (&acc)[2][2][4][2], const Unit& u, int wr, int wc, int fr, int fq) const {
        const int col0 = u.pn * BM + wc * 32 + 8 * fq; const int b = (row_off + u.pm * BM) >> 11;
        f32x4 gv[2][2];
#pragma unroll
        for (int bj = 0; bj < 2; ++bj)
#pragma unroll
            for (int n = 0; n < 2; ++n) gv[bj][n] = *(const f32x4*)(gate + (size_t)b * 3072 + col0 + bj * HALF + 4 * n);
#pragma unroll
        for (int ai = 0; ai < 2; ++ai)
#pragma unroll
            for (int m = 0; m < 4; ++m) { const size_t off = (size_t)(row_off + u.pm * BM + wr * 64 + fr + ai * HALF + m * 16) * 1024 + col0;
#pragma unroll
                for (int bj = 0; bj < 2; ++bj) { f32x4 b0, b1;
                    if (BASE_BF) { const u32x4 w = *(const u32x4*)((const bf16_t*)base + off + bj * HALF);
                        b0 = (f32x4){__uint_as_float(w.x << 16), __uint_as_float(w.x & 0xffff0000u), __uint_as_float(w.y << 16), __uint_as_float(w.y & 0xffff0000u)};
                        b1 = (f32x4){__uint_as_float(w.z << 16), __uint_as_float(w.z & 0xffff0000u), __uint_as_float(w.w << 16), __uint_as_float(w.w & 0xffff0000u)}; }
                    else { b0 = *(const f32x4*)((const float*)base + off + bj * HALF); b1 = *(const f32x4*)((const float*)base + off + bj * HALF + 4); }
                    const f32x4 v0 = b0 + gv[bj][0] * acc[ai][bj][m][0], v1 = b1 + gv[bj][1] * acc[ai][bj][m][1];
                    u32x4 o; o.x = cvt_pk_bf16(v0[0], v0[1]); o.y = cvt_pk_bf16(v0[2], v0[3]); o.z = cvt_pk_bf16(v1[0], v1[1]); o.w = cvt_pk_bf16(v1[2], v1[3]);
                    *(u32x4*)(outb + off + bj * HALF) = o; } }
    }
};
template <class Epi, class Sched, bool ALIGN_EPI = false, bool SP2 = false, bool AHM = false>
__device__ __forceinline__ void gemm_phase(PG8_LAS unsigned char* lds, const Gemm g, const Sched& S, const Epi& E, int tid_in) {
    const int tid = tid_in, wid = __builtin_amdgcn_readfirstlane(tid >> 6), lane = tid & 63, wr = wid >> 2, wc = wid & 3, fr = lane & 15, fq = lane >> 4;
    const int K = g.K, nt = K / BK;
    unsigned voffA[2], voffB[2];
#pragma unroll
    for (int i = 0; i < 2; ++i) { int R, C; stage_rc(tid * 16 + i * 8192, R, C); const int Rb = Epi::PERM ? ((R & ~31) + perm32(R & 31)) : R;
        voffA[i] = (unsigned)(R * (AHM ? 64 : K) + C) * 2u; voffB[i] = (unsigned)(Rb * K + C) * 2u; }
    const size_t kstep = (size_t)(BK * 2);
    const size_t hstep = (size_t)HALF * K * 2;
    const size_t tstep = 2 * hstep;
    const size_t kstepA = AHM ? (size_t)2048 * 128 : kstep, hstepA = AHM ? (size_t)HALF * 128 : hstep;
#define PG8_ATILE(pm_) ((const char*)g.A + (AHM ? ((size_t)((pm_) >> 3) * 32 * 2048 + (size_t)((pm_) & 7) * 256) * 128 : (size_t)(pm_) * tstep))
    const unsigned ldsw = (unsigned)wid * 1024u;
    const int aoff = lds_byte(wr * 64 + fr, fq * 8), boff = lds_byte(wc * 32 + fr, fq * 8);
#define PG8_SA(b, h) (((b) * 2 + (h)) * HTB)
#define PG8_SB(b, h) ((4 + (b) * 2 + (h)) * HTB)
#define PG8_STAGE(bufoff, gbase, voff) do { _Pragma("unroll") for (int _i = 0; _i < 2; ++_i) \
        __builtin_amdgcn_global_load_lds((const unsigned*)((const char*)(gbase) + (voff)[_i]), (PG8_LAS unsigned*)(lds + (bufoff) + ldsw + _i * 8192), 16, 0, 0); } while (0)
#define PG8_LDA(dst, b, h) do { _Pragma("unroll") for (int m = 0; m < 4; ++m) _Pragma("unroll") for (int k = 0; k < 2; ++k) dst[m][k] = *(const PG8_LAS bf16x8*)(lds + PG8_SA(b, h) + aoff + m * 2048 + k * 1024); } while (0)
#define PG8_LDB(dst, b, h) do { _Pragma("unroll") for (int n = 0; n < 2; ++n) _Pragma("unroll") for (int k = 0; k < 2; ++k) dst[n][k] = *(const PG8_LAS bf16x8*)(lds + PG8_SB(b, h) + boff + n * 2048 + k * 1024); } while (0)
#define PG8_MMA(ai, bj, At, Bt) do { __builtin_amdgcn_s_setprio(1); _Pragma("unroll") for (int m = 0; m < 4; ++m) _Pragma("unroll") for (int n = 0; n < 2; ++n) _Pragma("unroll") for (int k = 0; k < 2; ++k) \
        acc[ai][bj][m][n] = __builtin_amdgcn_mfma_f32_16x16x32_bf16(Bt[n][k], At[m][k], acc[ai][bj][m][n], 0, 0, 0); __builtin_amdgcn_s_setprio(0); } while (0)
#define PG8_WAIT_V(n) asm volatile("s_waitcnt vmcnt(" #n ")" ::: "memory")
#define PG8_WAIT_L(n) asm volatile("s_waitcnt lgkmcnt(" #n ")" ::: "memory")
#define PG8_BAR __builtin_amdgcn_s_barrier()
#define PG8_SCHED __builtin_amdgcn_sched_barrier(0)
    Unit cur, nxt; int ui = 0;
    if (!S.next(0, cur)) return;
    f32x4 acc[2][2][4][2];
#pragma unroll
    for (int a = 0; a < 2; ++a)
#pragma unroll
        for (int b = 0; b < 2; ++b)
#pragma unroll
            for (int m = 0; m < 4; ++m)
#pragma unroll
                for (int n = 0; n < 2; ++n) acc[a][b][m][n] = (f32x4){0.f, 0.f, 0.f, 0.f};
    bf16x8 At[4][2], B0[2][2], B1[2][2];
    const char* cA = PG8_ATILE(cur.pm); const char* cB = (const char*)g.Bt + (size_t)cur.pn * tstep;
    S.a_ready(cur);
    if constexpr (SP2) {
        PG8_STAGE(PG8_SB(0, 0), cB, voffB); PG8_STAGE(PG8_SB(0, 1), cB + hstep, voffB); PG8_STAGE(PG8_SA(0, 0), cA, voffA); PG8_STAGE(PG8_SA(0, 1), cA + hstepA, voffA);
        if (wr == 1) PG8_BAR;
        PG8_WAIT_V(2); PG8_BAR;
        PG8_STAGE(PG8_SB(1, 0), cB + kstep, voffB); PG8_STAGE(PG8_SA(1, 0), cA + kstepA, voffA); PG8_STAGE(PG8_SB(1, 1), cB + hstep + kstep, voffB);
        PG8_WAIT_V(6); PG8_BAR;
    } else {
        PG8_STAGE(PG8_SB(0, 0), cB, voffB); PG8_STAGE(PG8_SA(0, 0), cA, voffA); PG8_STAGE(PG8_SB(0, 1), cB + hstep, voffB); PG8_STAGE(PG8_SA(0, 1), cA + hstepA, voffA);
        if (wr == 1) PG8_BAR;
        PG8_WAIT_V(4); PG8_BAR;
        PG8_STAGE(PG8_SB(1, 0), cB + kstep, voffB); PG8_STAGE(PG8_SA(1, 0), cA + kstepA, voffA); PG8_STAGE(PG8_SB(1, 1), cB + hstep + kstep, voffB);
        PG8_WAIT_V(6); PG8_BAR;
    }
    for (;;) {
        const bool has_next = S.next(ui + 1, nxt);
        const char* nA = has_next ? PG8_ATILE(nxt.pm) : cA; const char* nB = has_next ? (const char*)g.Bt + (size_t)nxt.pn * tstep : cB;
        for (int t = 0; t < nt; t += 2) {
            const bool last = (t == nt - 2);
            const char* a1 = cA + (size_t)(t + 1) * kstepA;
            const char* a2 = last ? nA : cA + (size_t)(t + 2) * kstepA; const char* b2 = last ? nB : cB + (size_t)(t + 2) * kstep;
            const char* a3 = a2 + kstepA; const char* b3 = b2 + kstep;
            if (last && has_next) S.a_ready(nxt);
            if constexpr (SP2) {
            PG8_LDB(B0, 0, 0); PG8_LDB(B1, 0, 1); PG8_SCHED; PG8_LDA(At, 0, 0); PG8_STAGE(PG8_SA(1, 1), a1 + hstepA, voffA);
            PG8_WAIT_V(8); PG8_WAIT_L(0); PG8_BAR; PG8_MMA(0, 0, At, B0); PG8_MMA(0, 1, At, B1); PG8_BAR; PG8_SCHED;
            PG8_LDA(At, 0, 1); PG8_STAGE(PG8_SB(0, 0), b2, voffB); PG8_STAGE(PG8_SB(0, 1), b2 + hstep, voffB); PG8_STAGE(PG8_SA(0, 0), a2, voffA);
            PG8_WAIT_V(8); PG8_WAIT_L(0); PG8_BAR; PG8_MMA(1, 0, At, B0); PG8_MMA(1, 1, At, B1); PG8_BAR; PG8_SCHED;
            PG8_LDB(B0, 1, 0); PG8_LDB(B1, 1, 1); PG8_SCHED; PG8_LDA(At, 1, 0); PG8_STAGE(PG8_SA(0, 1), a2 + hstepA, voffA);
            PG8_WAIT_V(8); PG8_WAIT_L(0); PG8_BAR; PG8_MMA(0, 0, At, B0); PG8_MMA(0, 1, At, B1); PG8_BAR; PG8_SCHED;
            PG8_LDA(At, 1, 1); PG8_STAGE(PG8_SB(1, 0), b3, voffB); PG8_STAGE(PG8_SB(1, 1), b3 + hstep, voffB); PG8_STAGE(PG8_SA(1, 0), a3, voffA);
            PG8_WAIT_V(8); PG8_WAIT_L(0); PG8_BAR; PG8_MMA(1, 0, At, B0); PG8_MMA(1, 1, At, B1); PG8_BAR; PG8_SCHED;
            } else {
            PG8_LDB(B0, 0, 0); PG8_SCHED; PG8_LDA(At, 0, 0); PG8_STAGE(PG8_SA(1, 1), a1 + hstepA, voffA);
            PG8_WAIT_L(8); PG8_BAR; PG8_WAIT_L(0); PG8_MMA(0, 0, At, B0); PG8_BAR; PG8_SCHED;
            PG8_LDB(B1, 0, 1); PG8_STAGE(PG8_SB(0, 0), b2, voffB);
            PG8_BAR; PG8_WAIT_L(0); PG8_MMA(0, 1, At, B1); PG8_BAR;
            PG8_LDA(At, 0, 1); PG8_STAGE(PG8_SA(0, 0), a2, voffA);
            PG8_BAR; PG8_WAIT_L(0); PG8_MMA(1, 0, At, B0); PG8_BAR; PG8_SCHED;
            PG8_STAGE(PG8_SB(0, 1), b2 + hstep, voffB);
            PG8_WAIT_V(6); PG8_BAR; PG8_MMA(1, 1, At, B1); PG8_BAR;
            PG8_LDB(B0, 1, 0); PG8_SCHED; PG8_LDA(At, 1, 0); PG8_STAGE(PG8_SA(0, 1), a2 + hstepA, voffA);
            PG8_WAIT_L(8); PG8_BAR; PG8_WAIT_L(0); PG8_MMA(0, 0, At, B0); PG8_BAR; PG8_SCHED;
            PG8_LDB(B1, 1, 1); PG8_STAGE(PG8_SB(1, 0), b3, voffB);
            PG8_BAR; PG8_WAIT_L(0); PG8_MMA(0, 1, At, B1); PG8_BAR;
            PG8_LDA(At, 1, 1); PG8_STAGE(PG8_SA(1, 0), a3, voffA);
            PG8_BAR; PG8_WAIT_L(0); PG8_MMA(1, 0, At, B0); PG8_BAR; PG8_SCHED;
            PG8_STAGE(PG8_SB(1, 1), b3 + hstep, voffB);
            PG8_WAIT_V(6); PG8_BAR; PG8_MMA(1, 1, At, B1); PG8_BAR;
            }
        }
        if constexpr (ALIGN_EPI) { if (wr == 0) PG8_BAR; }
        if constexpr (!Epi::AFTER_DRAIN) { E(acc, cur, wr, wc, fr, fq); S.done(cur); }
        if (!has_next) break;
#pragma unroll
        for (int a = 0; a < 2; ++a)
#pragma unroll
            for (int b = 0; b < 2; ++b)
#pragma unroll
                for (int m = 0; m < 4; ++m)
#pragma unroll
                    for (int n = 0; n < 2; ++n) acc[a][b][m][n] = (f32x4){0.f, 0.f, 0.f, 0.f};
        cur = nxt; cA = nA; cB = nB; ++ui;
        if constexpr (ALIGN_EPI) { if (wr == 1) PG8_BAR; }
    }
    PG8_WAIT_V(0);
    if constexpr (!ALIGN_EPI) { if (wr == 0) PG8_BAR; }
    PG8_BAR;
    if constexpr (Epi::AFTER_DRAIN) { E.fused(acc, cur, wr, wc, fr, fq, lds, wid, lane); S.done(cur); }
#undef PG8_SA
#undef PG8_ATILE
#undef PG8_SB
#undef PG8_STAGE
#undef PG8_LDA
#undef PG8_LDB
#undef PG8_MMA
#undef PG8_WAIT_V
#undef PG8_WAIT_L
#undef PG8_BAR
#undef PG8_SCHED
}
}
namespace att {
typedef __hip_bfloat16 bf16;
typedef __attribute__((ext_vector_type(8))) short bf16x8;
typedef __attribute__((ext_vector_type(4))) short s16x4;
typedef __attribute__((ext_vector_type(16))) float f32x16;
typedef __attribute__((ext_vector_type(4))) float f32x4;
typedef __attribute__((ext_vector_type(4))) unsigned u32x4;
typedef __attribute__((ext_vector_type(2))) unsigned u32x2;
#define ALAS __attribute__((address_space(3)))
constexpr int PITCH = 64, SEQ = 2048, D = 64, QB = 256, KVB = 64, NQB = SEQ / QB;
constexpr int SLOTB = 16384, NSLOT = 6;
constexpr int L_CUM = NSLOT * SLOTB, L_WSF = L_CUM + SEQ * 4, L_MISC = L_WSF + 8 * 256, L_OST = L_MISC + 256, L_END = L_OST + 8 * 4096;
constexpr float C2 = 0.125f * 1.4426950408889634f;
__device__ __forceinline__ int crow(int r, int hi) { return (r & 3) + 8 * (r >> 2) + 4 * hi; }
__device__ __forceinline__ void glds16(const void* gsrc, unsigned lds_dst) { unsigned keep;
  asm volatile("s_mov_b32 %0, m0\n\ts_mov_b32 m0, %2\n\ts_nop 0\n\tglobal_load_lds_dwordx4 %1, off\n\ts_mov_b32 m0, %0" : "=&s"(keep) : "v"(gsrc), "s"(lds_dst) : "memory"); }
typedef float f32x2_t __attribute__((ext_vector_type(2))); typedef __bf16 bf16x2_t __attribute__((ext_vector_type(2)));
__device__ __forceinline__ unsigned cvtpk(float lo, float hi) { f32x2_t v = {lo, hi}; bf16x2_t b = __builtin_convertvector(v, bf16x2_t); return __builtin_bit_cast(unsigned, b); }
typedef short v4i16_t __attribute__((ext_vector_type(4)));
__device__ __forceinline__ s16x4 vtr(const ALAS char* p) { return __builtin_bit_cast(s16x4, __builtin_amdgcn_ds_read_tr16_b64_v4i16((ALAS v4i16_t*)p)); }
__device__ __forceinline__ float swap_sum(float v) { auto rr = __builtin_amdgcn_permlane32_swap(__float_as_uint(v), __float_as_uint(v), false, false); return __uint_as_float(rr[0]) + __uint_as_float(rr[1]); }
__device__ __forceinline__ float swap_max(float v) { auto rr = __builtin_amdgcn_permlane32_swap(__float_as_uint(v), __float_as_uint(v), false, false); return fmaxf(__uint_as_float(rr[0]), __uint_as_float(rr[1])); }
#define AWAIT_BAR(N) asm volatile("s_waitcnt vmcnt(" #N ") lgkmcnt(0)\n\ts_barrier" ::: "memory")

struct St { f32x16 o0, o1; float mhat, l, R; };
#define SCHED_FENCE() __builtin_amdgcn_sched_barrier(0)

__device__ __forceinline__ void k_frags(bf16x8 (&kf)[4], const ALAS char* kph, int kx) {
  asm volatile("" : "+v"(kx));
#pragma unroll
  for (int d0 = 0; d0 < 4; ++d0) kf[d0] = *(const ALAS bf16x8*)(kph + (kx ^ (d0 << 5)));
}
__device__ __forceinline__ void qk_half(f32x16& p, const bf16x8 (&kf)[4], const bf16x8* qr, const f32x16& c) {
  p = __builtin_amdgcn_mfma_f32_32x32x16_bf16(kf[0], qr[0], c, 0, 0, 0);
#pragma unroll
  for (int d0 = 1; d0 < 4; ++d0) p = __builtin_amdgcn_mfma_f32_32x32x16_bf16(kf[d0], qr[d0], p, 0, 0, 0);
}
struct VF { bf16x8 v[2][2]; };
__device__ __forceinline__ void v_frags(VF& f, const ALAS char* vph) {
#pragma unroll
  for (int k2 = 0; k2 < 2; ++k2) {
    const s16x4 a0 = vtr(vph + k2 * 2048), a1 = vtr(vph + k2 * 2048 + 1024), b0 = vtr(vph + 512 + k2 * 2048), b1 = vtr(vph + 512 + k2 * 2048 + 1024);
    f.v[k2][0] = (bf16x8){a0[0], a0[1], a0[2], a0[3], a1[0], a1[1], a1[2], a1[3]};
    f.v[k2][1] = (bf16x8){b0[0], b0[1], b0[2], b0[3], b1[0], b1[1], b1[2], b1[3]};
  }
}
__device__ __forceinline__ void pv_half(St& s, const VF& f, const f32x16& p) {
  const u32x4 pw0 = (u32x4){cvtpk(p[0], p[1]), cvtpk(p[2], p[3]), cvtpk(p[4], p[5]), cvtpk(p[6], p[7])};
  const u32x4 pw1 = (u32x4){cvtpk(p[8], p[9]), cvtpk(p[10], p[11]), cvtpk(p[12], p[13]), cvtpk(p[14], p[15])};
  s.o0 = __builtin_amdgcn_mfma_f32_32x32x16_bf16(__builtin_bit_cast(bf16x8, pw0), f.v[0][0], s.o0, 0, 0, 0);
  s.o1 = __builtin_amdgcn_mfma_f32_32x32x16_bf16(__builtin_bit_cast(bf16x8, pw0), f.v[0][1], s.o1, 0, 0, 0);
  s.o0 = __builtin_amdgcn_mfma_f32_32x32x16_bf16(__builtin_bit_cast(bf16x8, pw1), f.v[1][0], s.o0, 0, 0, 0);
  s.o1 = __builtin_amdgcn_mfma_f32_32x32x16_bf16(__builtin_bit_cast(bf16x8, pw1), f.v[1][1], s.o1, 0, 0, 0);
}

template <bool STRICT>
__device__ __forceinline__ void tri_mask(f32x16& P, int rr, int hi) {
  float t = ((float)(rr - 4 * hi) + (STRICT ? -0.5f : 0.5f)) * 0x1p100f;
#pragma unroll
  for (int r = 0; r < 16; ++r) { P[r] = fminf(P[r], t); t -= ((r & 3) == 3) ? 5.0f * 0x1p100f : 0x1p100f; }
}

template <bool TRI, bool FIRST>
__device__ __forceinline__ float fox_soft(St& s, f32x16& p, int rr, int hi, int r32, ALAS float* wsf) {
  if (TRI) tri_mask<false>(p, rr, hi);
  float a = fmaxf(p[0], p[1]);
#pragma unroll
  for (int r = 2; r < 16; ++r) a = fmaxf(a, p[r]);
  const float rm = swap_max(a);
  float dl = 0.f;
  if (FIRST) {
    dl = rm; s.mhat += rm;
#pragma unroll
    for (int r = 0; r < 16; ++r) p[r] -= rm;
  } else if (__any(rm > 8.0f)) {
    dl = fmaxf(rm, 0.f); s.mhat += dl;
#pragma unroll
    for (int r = 0; r < 16; ++r) p[r] -= dl;
    const float f = __builtin_amdgcn_exp2f(-dl); s.l *= f;
    if (hi == 0) wsf[r32] = f;
    asm volatile("s_waitcnt lgkmcnt(0)" ::: "memory");
#pragma unroll
    for (int r = 0; r < 16; ++r) { const float fr_ = wsf[crow(r, hi)]; s.o0[r] *= fr_; s.o1[r] *= fr_; }
    asm volatile("s_waitcnt lgkmcnt(0)" ::: "memory");
  }
  float sum = 0.f;
#pragma unroll
  for (int r = 0; r < 16; ++r) { p[r] = __builtin_amdgcn_exp2f(p[r]); sum += p[r]; }
  s.l += sum;
  return dl;
}
template <bool DIAG>
__device__ __forceinline__ void fox_tile(St& s, const ALAS char* kp, int kx, const ALAS char* vp, const bf16x8* qr, const ALAS float* ck, float cq2, int qrel, int hi, int r32, ALAS float* wsf) {
  const float cb = cq2 - s.mhat;
  const bool lowrows = DIAG && (qrel < 32);
  f32x16 p0, p1; bf16x8 kf0[4], kf1[4];
  k_frags(kf0, kp, kx);
  if (!lowrows) {
    k_frags(kf1, kp + 4096, kx);
#pragma unroll
    for (int g = 0; g < 4; ++g) { const f32x4 b = *(const ALAS f32x4*)(ck + 32 + 8 * g + 4 * hi);
#pragma unroll
      for (int i = 0; i < 4; ++i) p1[4 * g + i] = cb - b[i]; }
    qk_half(p1, kf1, qr, p1);
  }
#pragma unroll
  for (int g = 0; g < 4; ++g) { const f32x4 a = *(const ALAS f32x4*)(ck + 8 * g + 4 * hi);
#pragma unroll
    for (int i = 0; i < 4; ++i) p0[4 * g + i] = cb - a[i]; }
  qk_half(p0, kf0, qr, p0);
  SCHED_FENCE();
  VF vf;
  if (!lowrows) {
    v_frags(vf, vp + 4096);
    const float dl = DIAG ? fox_soft<true, true>(s, p1, qrel - 32, hi, r32, wsf) : fox_soft<false, false>(s, p1, 0, hi, r32, wsf);
    SCHED_FENCE();
    pv_half(s, vf, p1);
    if (DIAG || __any(dl != 0.f)) {
#pragma unroll
      for (int r = 0; r < 16; ++r) p0[r] -= dl;
    }
    SCHED_FENCE();
    v_frags(vf, vp);
    fox_soft<false, false>(s, p0, 0, hi, r32, wsf);
  } else {
    v_frags(vf, vp);
    fox_soft<true, true>(s, p0, qrel, hi, r32, wsf);
  }
  SCHED_FENCE();
  pv_half(s, vf, p0);
}

template <bool TRI>
__device__ __forceinline__ void sb_half(f32x16& P, float& Y, int rr, int hi) {
  if (TRI) tri_mask<true>(P, rr, hi);
#pragma unroll
  for (int r = 0; r < 16; ++r) { const float e = __builtin_amdgcn_exp2f(P[r]); P[r] = __builtin_amdgcn_rcpf(1.0f + e); }
#pragma unroll
  for (int g = 3; g >= 0; --g) {
    const float k0 = P[4 * g], k1 = P[4 * g + 1], k2 = P[4 * g + 2], k3 = P[4 * g + 3];
    const float t1 = k3 * k2, t0 = t1 * k1, G = t0 * k0;
    auto rr_ = __builtin_amdgcn_permlane32_swap(__float_as_uint(G), __float_as_uint(G), false, false);
    const float Go = __uint_as_float(rr_[0]), Ge = __uint_as_float(rr_[1]);
    const float Y1 = Y * Ge, Y2 = Y1 * Go;
    const float X = hi ? Y : Y1, XG = hi ? Y1 : Y2;
    const float pe2 = X * k3, pe1 = X * t1, pe0 = X * t0;
    P[4 * g + 3] = X - pe2; P[4 * g + 2] = pe2 - pe1; P[4 * g + 1] = pe1 - pe0; P[4 * g] = pe0 - XG;
    Y = Y2;
  }
}
template <bool DIAG>
__device__ __forceinline__ void sb_tile(St& s, const ALAS char* kp, int kx, const ALAS char* vp, const bf16x8* qr, int qrel, int hi) {
  const bool lowrows = DIAG && (qrel < 32);
  f32x16 p0, p1; bf16x8 kf0[4], kf1[4]; const f32x16 z = {};
  k_frags(kf0, kp, kx);
  if (!lowrows) { k_frags(kf1, kp + 4096, kx); qk_half(p1, kf1, qr, z); }
  qk_half(p0, kf0, qr, z);
  SCHED_FENCE();
  VF vf; float Y = s.R;
  if (!lowrows) {
    v_frags(vf, vp + 4096);
    if (DIAG) sb_half<true>(p1, Y, qrel - 32, hi); else sb_half<false>(p1, Y, 0, hi);
    SCHED_FENCE();
    pv_half(s, vf, p1);
    SCHED_FENCE();
    v_frags(vf, vp);
    sb_half<false>(p0, Y, 0, hi);
  } else {
    v_frags(vf, vp);
    sb_half<true>(p0, Y, qrel, hi);
  }
  SCHED_FENCE();
  pv_half(s, vf, p0);
  s.R = Y;
}

template <int MODE>
__device__ __forceinline__ void bh_item(int rowbase, int qb_hi, int qb_lo, const bf16* Q, const bf16* K, const bf16* V, const bf16* Z, bf16* O, ALAS char* shm3, int tid_in) {
  const int tid = tid_in, lane = tid & 63, r32 = lane & 31, hi = lane >> 5; const int wid = __builtin_amdgcn_readfirstlane(tid >> 6);
  const int pr = wid >> 1, w2 = (wid ^ (wid >> 2)) & 1, wrow = 64 * pr + 32 * w2;
  const bf16* Kh = K + (size_t)rowbase * PITCH; const bf16* Vh = V + (size_t)rowbase * PITCH;
  const unsigned lds0 = (unsigned)(uintptr_t)shm3;
  ALAS float* wsf = (ALAS float*)(shm3 + L_WSF) + wid * 64;
  const ALAS float* cum = (const ALAS float*)(shm3 + L_CUM);
  ALAS unsigned* misc = (ALAS unsigned*)(shm3 + L_MISC);
  const bf16* ksrc = Kh + (size_t)(8 * wid + (lane >> 3)) * PITCH + (((lane & 7) ^ (((8 * wid + (lane >> 3)) >> 1) & 7)) * 8);
  const bf16* vsrc = Vh + (size_t)(8 * wid + ((lane & 31) >> 2)) * PITCH + (lane >> 5) * 32 + (lane & 3) * 8;
  const unsigned kdst = lds0 + wid * 1024, vdst = lds0 + 8192 + wid * 1024;
#define DMA_KV(jt) do { const int sl_ = (jt) % NSLOT; glds16(ksrc + (size_t)(jt) * KVB * PITCH, (unsigned)__builtin_amdgcn_readfirstlane(kdst + sl_ * SLOTB)); \
                        glds16(vsrc + (size_t)(jt) * KVB * PITCH, (unsigned)__builtin_amdgcn_readfirstlane(vdst + sl_ * SLOTB)); } while (0)
#define ISSUE_UNIT(qb_, QR, NDMA) do { const int nb0_ = 4 * (qb_); const int tlo_ = (lo >= nb0_ - 1) ? (nb0_ > 0 ? nb0_ - 1 : 0) : nb0_ - 2; NDMA = 0; \
    for (int j_ = nb0_ + 3; j_ >= tlo_; --j_) if (j_ < lo || j_ > lo + 5) { DMA_KV(j_); ++NDMA; } \
    lo = tlo_; \
    const bf16* Qw_ = Q + (size_t)(rowbase + (qb_) * QB + wrow) * PITCH; \
    _Pragma("unroll") for (int d0 = 0; d0 < 4; ++d0) QR[d0] = *(const bf16x8*)(Qw_ + (size_t)r32 * PITCH + d0 * 16 + hi * 8); } while (0)
#define LOAD_Z(qb_, ZZ) do { const bf16* Zw_ = Z + (size_t)(rowbase + (qb_) * QB + wrow) * PITCH; \
    _Pragma("unroll") for (int i_ = 0; i_ < 4; ++i_) ZZ[i_] = *(const u32x4*)(Zw_ + (size_t)(i_ * 8 + (lane >> 3)) * PITCH + (lane & 7) * 8); } while (0)
  const ALAS char* kp0 = shm3 + r32 * 128;
  const int kx = ((hi ^ (r32 >> 1)) & 7) << 4;
  const ALAS char* vp0 = shm3 + 8192 + ((lane >> 4) & 1) * 32 + (lane & 3) * 8 + (4 * hi + ((lane & 15) >> 2)) * 64;
  const int qrel = w2 * 32 + r32;
  bf16x8 qr[4]; int lo = 1 << 20, ndma = 0;
  ISSUE_UNIT(qb_hi, qr, ndma);
  for (int qb = qb_hi; qb >= qb_lo; --qb) {
    const int q0 = qb * QB, jb0 = 4 * qb, jd = jb0 + pr;
    AWAIT_BAR(0);
    {
      const bf16* Zw_ = Z + (size_t)(rowbase + q0 + wrow) * PITCH + (size_t)lane * 8;
      const unsigned zdst = (unsigned)__builtin_amdgcn_readfirstlane(lds0 + L_OST + wid * 4096);
#pragma unroll
      for (int i_ = 0; i_ < 4; ++i_) glds16(Zw_ + (size_t)i_ * 8 * PITCH, zdst + i_ * 1024);
    }
    St s; s.o0 = f32x16{}; s.o1 = f32x16{}; s.mhat = 0.f; s.l = 0.f; s.R = 1.0f;
    float cq2 = 0.f, qkb = 0.f;
    if (MODE == 0) {
      cq2 = cum[q0 + wrow + r32];
      float n2l = 0.f, n2h = 0.f;
#pragma unroll
      for (int d0 = 0; d0 < 4; ++d0)
#pragma unroll
        for (int e = 0; e < 8; ++e) { const float v = __uint_as_float(((unsigned)(unsigned short)qr[d0][e]) << 16); if (d0 < 2) n2l += v * v; else n2h += v * v; }
      qkb = (sqrtf(swap_sum(n2l)) * __uint_as_float(misc[1]) + sqrtf(swap_sum(n2h)) * __uint_as_float(misc[2])) * 1.0001f;
    }
    bool done = false;
    const int NSTEP = jb0 + 4;
    for (int i = 0; i < NSTEP; ++i) {
      const int jt = jd - i, pre = jb0 - i - 2;
      const bool issued = (pre >= 0 && pre < lo);
      if (issued) { DMA_KV(pre); lo = pre; }
      if (!done) {
        if (jt < 0) done = true;
        else {
          const int sl = jt % NSLOT;
          const ALAS char* kp = kp0 + sl * SLOTB; const ALAS char* vp = vp0 + sl * SLOTB;
          if (MODE == 0) {
            if (i == 0) fox_tile<true>(s, kp, kx, vp, qr, cum + 64 * jt, cq2, qrel, hi, r32, wsf);
            else fox_tile<false>(s, kp, kx, vp, qr, cum + 64 * jt, cq2, qrel, hi, r32, wsf);
            if (jt == 0) done = true;
            else { const float cprev = cum[64 * jt - 1]; done = __all((11.0f + qkb + cq2 - cprev - s.mhat) < -32.0f) != 0; }
          } else {
            if (i == 0) sb_tile<true>(s, kp, kx, vp, qr, qrel, hi);
            else sb_tile<false>(s, kp, kx, vp, qr, qrel, hi);
            if (jt == 0) done = true;
            else done = __all(s.R < 0x1p-40f) != 0;
          }
        }
      }
      if (lane == 0) misc[8 + 8 * (i & 1) + wid] = done ? 1u : 0u;
      if (issued) AWAIT_BAR(2); else AWAIT_BAR(0);
      const u32x4 f0 = *(const ALAS u32x4*)(misc + 8 + 8 * (i & 1)), f1 = *(const ALAS u32x4*)(misc + 12 + 8 * (i & 1));
      const unsigned alld = (f0[0] & f0[1] & f0[2] & f0[3]) & (f1[0] & f1[1] & f1[2] & f1[3]);
      if (__builtin_amdgcn_readfirstlane(alld)) break;
    }
    if (qb > qb_lo) ISSUE_UNIT(qb - 1, qr, ndma);
    if (MODE == 0) {
      const float lt = swap_sum(s.l); const float inv = __builtin_amdgcn_rcpf(lt);
      if (hi == 0) wsf[r32] = inv;
      asm volatile("s_waitcnt lgkmcnt(0)" ::: "memory");
#pragma unroll
      for (int r = 0; r < 16; ++r) { const float f = wsf[crow(r, hi)]; s.o0[r] *= f; s.o1[r] *= f; }
    }
    ALAS float* stg = (ALAS float*)(shm3 + L_OST + wid * 4096);
    u32x4 zz[4];
#pragma unroll
    for (int i_ = 0; i_ < 4; ++i_) zz[i_] = *(const ALAS u32x4*)(shm3 + L_OST + wid * 4096 + i_ * 1024 + lane * 16);
    asm volatile("s_waitcnt lgkmcnt(0)" ::: "memory");
    bf16* Ow = O + (size_t)(rowbase + q0 + wrow) * PITCH;
#pragma unroll
    for (int ps = 0; ps < 2; ++ps) {
#pragma unroll
      for (int r8 = 0; r8 < 8; ++r8) { const int r = ps * 8 + r8; const int orow = crow(r8, hi); stg[orow * 64 + r32] = s.o0[r]; stg[orow * 64 + 32 + r32] = s.o1[r]; }
      asm volatile("s_waitcnt lgkmcnt(0)" ::: "memory");
#pragma unroll
      for (int i2 = 0; i2 < 2; ++i2) {
        const int row = i2 * 8 + (lane >> 3), ch = lane & 7, i = ps * 2 + i2;
        const f32x4 a = *(const ALAS f32x4*)(stg + row * 64 + ch * 8), b = *(const ALAS f32x4*)(stg + row * 64 + ch * 8 + 4);
        float ov[8] = {a[0], a[1], a[2], a[3], b[0], b[1], b[2], b[3]};
        unsigned w[4];
#pragma unroll
        for (int e = 0; e < 4; ++e) {
          const float z0 = __uint_as_float(zz[i][e] << 16), z1 = __uint_as_float(zz[i][e] & 0xffff0000u);
          const float g0 = z0 * __builtin_amdgcn_rcpf(1.0f + __builtin_amdgcn_exp2f(-1.4426950408889634f * z0));
          const float g1 = z1 * __builtin_amdgcn_rcpf(1.0f + __builtin_amdgcn_exp2f(-1.4426950408889634f * z1));
          w[e] = cvtpk(ov[2 * e] * g0, ov[2 * e + 1] * g1);
        }
        *(u32x4*)(Ow + (size_t)(ps * 16 + row) * PITCH + ch * 8) = (u32x4){w[0], w[1], w[2], w[3]};
      }
      asm volatile("s_waitcnt lgkmcnt(0)" ::: "memory");
    }
  }
  asm volatile("s_waitcnt vmcnt(0)" ::: "memory");
#undef DMA_KV
#undef ISSUE_UNIT
#undef LOAD_Z
}
}
constexpr int NWAVES = 8;
constexpr int DM = 1024, NB = 32, SEQ = 2048, MTOK = NB * SEQ, DI = 2048, NH = 32;
constexpr int NCHUNK = 2, CH = MTOK / NCHUNK, CHB = NB / NCHUNK;
constexpr int NIN0 = 8448, NIN0_REAL = 8224, NIN1 = 8192;
constexpr float NORM_EPS = 1e-6f;
constexpr size_t MiB = 1u << 20;
constexpr size_t WS_WIN0 = 0, WS_WIN1 = 17 * MiB, WS_WOUT0 = 33 * MiB, WS_WOUT1 = 37 * MiB, WS_MOD = 41 * MiB, WS_LOGF = 42 * MiB, WS_H = 46 * MiB, WS_Q = 110 * MiB;
constexpr size_t WS_CNT = WS_MOD + 0xE0000;
constexpr size_t WS_KMX = WS_MOD + 0xE8000;
constexpr size_t WS_BAR = WS_MOD + 0xE1000;
constexpr int LDS_BARST = 147200;
constexpr size_t QKVZ_STRIDE = (size_t)CH * DI;
constexpr size_t WS_X1B = WS_Q + 4 * QKVZ_STRIDE * 2, WS_X2B = WS_X1B + (size_t)MTOK * DM * 2;
constexpr size_t WS_END = WS_X2B + (size_t)MTOK * DM * 2;
static_assert((size_t)NIN0 * DM * 2 <= WS_WIN1 && (size_t)CH * 32 * 4 <= WS_H - WS_LOGF && (size_t)CH * DM * 2 <= WS_Q - WS_H, "d_ws map");
constexpr int RING_BYTES = 131072, LDS_BYTES = 147456;
static_assert(att::L_END <= LDS_BYTES, "attention LDS map");
#define GAS __attribute__((address_space(1)))
#define LAS __attribute__((address_space(3)))
typedef unsigned short bf16raw;
typedef unsigned v4u __attribute__((ext_vector_type(4)));
typedef float f32x4 __attribute__((ext_vector_type(4)));
#define LDS_WAIT() asm volatile("s_waitcnt lgkmcnt(0)" ::: "memory")
__device__ __forceinline__ unsigned f2bf(float f) { unsigned u = __builtin_bit_cast(unsigned, f); return (u + 0x7fffu + ((u >> 16) & 1u)) >> 16; }
__device__ __forceinline__ unsigned pk2(float lo, float hi) { return f2bf(lo) | (f2bf(hi) << 16); }
__device__ __forceinline__ float wave_sum(float v) {
#pragma unroll
    for (int o = 1; o < 64; o <<= 1) v += __shfl_xor(v, o);
    return v;
}
struct Params { const float *x, *c, *fng, *fwada, *fbada, *fwin, *fbf, *fwout, *sng, *swada, *sbada, *swin, *swout, *fing; float* out; unsigned char* ws; };

__device__ __forceinline__ void transpose_item(const float* W, int K, int N, bf16raw* WT, LAS float* scr, int item, int lane) {
    const int nblk = N / 32, kb = item / nblk, nb = item % nblk, k0 = 64 * kb, n0 = 32 * nb;
#pragma unroll 8
    for (int i = 0; i < 32; ++i) { const int kk = 2 * i + (lane >> 5); scr[kk * 33 + (lane & 31)] = W[(size_t)(k0 + kk) * N + n0 + (lane & 31)]; }
    LDS_WAIT(); asm volatile("" ::: "memory");
    const int c = lane & 7;
#pragma unroll
    for (int j = 0; j < 4; ++j) { const int n = (lane >> 3) + 8 * j; const LAS float* s = scr + (8 * c) * 33 + n;
        v4u o; o.x = pk2(s[0 * 33], s[1 * 33]); o.y = pk2(s[2 * 33], s[3 * 33]); o.z = pk2(s[4 * 33], s[5 * 33]); o.w = pk2(s[6 * 33], s[7 * 33]);
        *(v4u*)(WT + (size_t)(n0 + n) * K + k0 + 8 * c) = o; }
    LDS_WAIT(); asm volatile("" ::: "memory");
}

__device__ __forceinline__ void ada_item(const float* c, const float* W, const float* bias, float* mod, int cb, LAS unsigned char* lds, int tid) {
    const int lane = tid & 63, wave = tid >> 6;
    LAS float* sc = (LAS float*)lds + wave * 4096;
    for (int i = lane; i < 4096; i += 64) { const int b = i >> 7, kk = i & 127; const float v = c[b * DM + wave * 128 + kk]; sc[i] = v / (1.0f + __expf(-v)); }
    LDS_WAIT(); asm volatile("" ::: "memory");
    float acc[32];
#pragma unroll
    for (int b = 0; b < 32; ++b) acc[b] = 0.f;
    const float* Wp = W + (size_t)(wave * 128) * 3072 + cb * 64 + lane;
    for (int kk = 0; kk < 128; kk += 4) {
        const float w0 = Wp[(size_t)(kk + 0) * 3072], w1 = Wp[(size_t)(kk + 1) * 3072], w2 = Wp[(size_t)(kk + 2) * 3072], w3 = Wp[(size_t)(kk + 3) * 3072];
#pragma unroll
        for (int b = 0; b < 32; ++b) { const f32x4 s4 = *(const LAS f32x4*)(sc + b * 128 + kk); acc[b] += s4[0] * w0 + s4[1] * w1 + s4[2] * w2 + s4[3] * w3; }
    }
    __syncthreads();
    LAS float* red = (LAS float*)lds;
#pragma unroll
    for (int b = 0; b < 32; ++b) red[(wave * 32 + b) * 64 + lane] = acc[b];
    __syncthreads();
    for (int o = tid; o < 2048; o += 512) { const int b = o >> 6, col = o & 63; float sacc = 0.f;
#pragma unroll
        for (int w = 0; w < 8; ++w) sacc += red[(w * 32 + b) * 64 + col];
        mod[(size_t)b * 3072 + cb * 64 + col] = sacc + bias[cb * 64 + col]; }
    __syncthreads();
}

template <bool BF> __device__ __forceinline__ f32x4 ld_row4(const void* src, size_t row, int lane, int j) {
    if (BF) { typedef unsigned u32x2_ __attribute__((ext_vector_type(2))); const u32x2_ w = *((const u32x2_*)((const bf16raw*)src + row * DM) + lane + 64 * j);
        return (f32x4){__uint_as_float(w.x << 16), __uint_as_float(w.x & 0xffff0000u), __uint_as_float(w.y << 16), __uint_as_float(w.y & 0xffff0000u)}; }
    return *((const f32x4*)((const float*)src + row * DM) + lane + 64 * j);
}
template <bool BF>
__device__ __forceinline__ void norm_rows(const void* src, const float* g, const float* mod, bf16raw* H, int grow0, int lrow0, int nrows, int lane) {
    const int b = grow0 >> 11;
    f32x4 mul[4], add[4];
#pragma unroll
    for (int j = 0; j < 4; ++j) { const f32x4 gg = *(const f32x4*)(g + 4 * lane + 256 * j), sc = *(const f32x4*)(mod + (size_t)b * 3072 + 1024 + 4 * lane + 256 * j);
        mul[j] = gg * (sc + 1.0f); add[j] = *(const f32x4*)(mod + (size_t)b * 3072 + 4 * lane + 256 * j); }
    for (int r = 0; r < nrows; r += 4) {
        f32x4 v[4][4]; float s[4];
#pragma unroll
        for (int q = 0; q < 4; ++q) {
#pragma unroll
            for (int j = 0; j < 4; ++j) v[q][j] = ld_row4<BF>(src, (size_t)(grow0 + r + q), lane, j); }
#pragma unroll
        for (int q = 0; q < 4; ++q) { s[q] = 0.f;
#pragma unroll
            for (int j = 0; j < 4; ++j) s[q] += (v[q][j].x * v[q][j].x + v[q][j].y * v[q][j].y) + (v[q][j].z * v[q][j].z + v[q][j].w * v[q][j].w); }
#pragma unroll
        for (int o = 1; o < 64; o <<= 1) {
#pragma unroll
            for (int q = 0; q < 4; ++q) s[q] += __shfl_xor(s[q], o); }
#pragma unroll
        for (int q = 0; q < 4; ++q) { const float rstd = 1.0f / sqrtf(s[q] * (1.0f / DM) + NORM_EPS);
            unsigned long long* o8 = (unsigned long long*)(H + (size_t)(lrow0 + r + q) * DM) + lane;
#pragma unroll
            for (int j = 0; j < 4; ++j) { const f32x4 y = v[q][j] * rstd * mul[j] + add[j];
                o8[64 * j] = (unsigned long long)pk2(y.x, y.y) | ((unsigned long long)pk2(y.z, y.w) << 32); } }
    }
}
__device__ __forceinline__ void final_norm_rows(const bf16raw* x2, float* out, const float* g, int row0, int nrows, int lane) {
    f32x4 mul[4];
#pragma unroll
    for (int j = 0; j < 4; ++j) mul[j] = *(const f32x4*)(g + 4 * lane + 256 * j);
    for (int r = 0; r < nrows; r += 4) {
        f32x4 v[4][4]; float s[4];
#pragma unroll
        for (int q = 0; q < 4; ++q) {
#pragma unroll
            for (int j = 0; j < 4; ++j) v[q][j] = ld_row4<true>(x2, (size_t)(row0 + r + q), lane, j); }
#pragma unroll
        for (int q = 0; q < 4; ++q) { s[q] = 0.f;
#pragma unroll
            for (int j = 0; j < 4; ++j) s[q] += (v[q][j].x * v[q][j].x + v[q][j].y * v[q][j].y) + (v[q][j].z * v[q][j].z + v[q][j].w * v[q][j].w); }
#pragma unroll
        for (int o = 1; o < 64; o <<= 1) {
#pragma unroll
            for (int q = 0; q < 4; ++q) s[q] += __shfl_xor(s[q], o); }
#pragma unroll
        for (int q = 0; q < 4; ++q) { const float rstd = 1.0f / sqrtf(s[q] * (1.0f / DM) + NORM_EPS);
            f32x4* xw = (f32x4*)(out + (size_t)(row0 + r + q) * DM) + lane;
#pragma unroll
            for (int j = 0; j < 4; ++j) xw[64 * j] = v[q][j] * rstd * mul[j]; }
    }
}

__device__ __forceinline__ void fox_prep(const float* lf, const unsigned* kmx, int tok0, int h, LAS unsigned char* lds, int tid) {
    LAS float* cum = (LAS float*)(lds + att::L_CUM); LAS float* tot = (LAS float*)(lds + att::L_WSF); LAS unsigned* misc = (LAS unsigned*)(lds + att::L_MISC);
    __syncthreads();
    const int lane = tid & 63, wave = tid >> 6;
    const f32x4 lv = *(const f32x4*)(lf + ((size_t)((tok0 >> 11) * 32 + h)) * 2048 + 4 * tid);
    float a0 = lv[0], a1 = lv[1], a2 = lv[2], a3 = lv[3];
    a1 += a0; a2 += a1; a3 += a2;
    float inc = a3;
#pragma unroll
    for (int o = 1; o < 64; o <<= 1) { const float t = __int_as_float(__builtin_amdgcn_ds_bpermute((lane >= o ? lane - o : lane) << 2, __float_as_int(inc))); if (lane >= o) inc += t; }
    if (lane == 63) tot[wave] = inc;
    __syncthreads();
    float base = inc - a3;
    for (int w = 0; w < wave; ++w) base += tot[w];
    *(LAS f32x4*)(cum + 4 * tid) = (f32x4){a0 + base, a1 + base, a2 + base, a3 + base};
    if (tid < 2) misc[1 + tid] = __float_as_uint(sqrtf(__uint_as_float(__hip_atomic_load(kmx + tid, __ATOMIC_RELAXED, __HIP_MEMORY_SCOPE_AGENT))));
    __syncthreads();
}

#define XB_TMO      128
#define XB_XCNT(j)  (256  + 64 * (j))
#define XB_XSUB(j)  (1280 + 64 * (j))
#define XB_XGEN(j)  (2304 + 64 * (j))
#define XB_TOP      3328
#define XB_TOPGEN   3392
#define XCD_BAR_WORDS 3456
#define XB_SPIN_CAP (1u << 18)

__device__ __forceinline__ unsigned xb_ld(unsigned* p)              { return __hip_atomic_load(p, __ATOMIC_RELAXED, __HIP_MEMORY_SCOPE_AGENT); }
__device__ __forceinline__ unsigned xb_add(unsigned* p, unsigned v) { return __hip_atomic_fetch_add(p, v, __ATOMIC_RELAXED, __HIP_MEMORY_SCOPE_AGENT); }
__device__ __forceinline__ unsigned xb_xcc_id() { return (unsigned)__builtin_amdgcn_s_getreg((3 << 11) | 20) & 0xFu; }
#define XB_SPIN(cond, bar) do { unsigned _sp = 0; while (cond) { __builtin_amdgcn_s_sleep(1); \
    if ((++_sp & 255u) == 0u) { if (xb_ld(&(bar)[XB_TMO])) break; if (_sp > XB_SPIN_CAP) { atomicAdd(&(bar)[XB_TMO], 1u); break; } } } } while (0)

struct XcdBarrier {
    unsigned* bar; unsigned x;
    volatile LAS unsigned* st;
};

__device__ __forceinline__ XcdBarrier xcd_barrier_post(unsigned* bar, volatile LAS unsigned* st) {
    XcdBarrier b; b.bar = bar; b.x = xb_xcc_id(); b.st = st;
    if (threadIdx.x == 0) (void)xb_add(&bar[XB_XCNT(b.x)], 1u);
    return b;
}
__device__ __forceinline__ void xcd_barrier_complete(unsigned* bar, unsigned x, unsigned& nloc, unsigned& nx) {
    const unsigned G = gridDim.x * gridDim.y * gridDim.z;
    unsigned sum, cnt, mine, sp = 0u;
    for (;;) {
        sum = 0u; cnt = 0u; mine = 0u;
#pragma unroll
        for (unsigned j = 0; j < 16; ++j) { const unsigned c = xb_ld(&bar[XB_XCNT(j)]); sum += c; cnt += (c > 0u) ? 1u : 0u; mine = (j == x) ? c : mine; }
        if (sum == G) break;
        __builtin_amdgcn_s_sleep(1);
        if ((++sp & 255u) == 0u) { if (xb_ld(&bar[XB_TMO])) break; if (sp > XB_SPIN_CAP) { atomicAdd(&bar[XB_TMO], 1u); break; } }
    }
    nloc = mine > 0u ? mine : 1u; nx = cnt > 0u ? cnt : 1u;
}

__device__ __forceinline__ void xcd_barrier(const XcdBarrier& b) {
    asm volatile("s_waitcnt vmcnt(0)" ::: "memory");
    __syncthreads();
    if (threadIdx.x == 0) {
        unsigned* bar = b.bar;
        __builtin_amdgcn_s_waitcnt(0);
        unsigned nloc = b.st[0], nx = b.st[1];
        if (nloc == 0u) { xcd_barrier_complete(bar, b.x, nloc, nx); b.st[0] = nloc; b.st[1] = nx; }
        const unsigned old = xb_add(&bar[XB_XSUB(b.x)], 1u);
        const unsigned gen = old / nloc;
        if (old + 1u == (gen + 1u) * nloc) {
            __builtin_amdgcn_fence(__ATOMIC_RELEASE, "agent");
            asm volatile("s_waitcnt vmcnt(0)" ::: "memory");
            const unsigned og = xb_add(&bar[XB_TOP], 1u);
            const unsigned tg = og / nx;
            if (og + 1u == (tg + 1u) * nx) xb_add(&bar[XB_TOPGEN], 1u);
            else XB_SPIN(xb_ld(&bar[XB_TOPGEN]) == tg, bar);
            __builtin_amdgcn_fence(__ATOMIC_ACQUIRE, "agent");
            xb_add(&bar[XB_XGEN(b.x)], 1u);
            asm volatile("s_waitcnt vmcnt(0)" ::: "memory");
        } else {
            XB_SPIN(xb_ld(&bar[XB_XGEN(b.x)]) == gen, bar);
            __builtin_amdgcn_fence(__ATOMIC_ACQUIRE, "agent");
            asm volatile("s_waitcnt vmcnt(0)" ::: "memory");
        }
    }
    __syncthreads();
}

__device__ __forceinline__ void forget_task(const bf16raw* H, const bf16raw* Wf, const float* bfb, float* lf, int row0, int lane) {
    typedef short bf16x8_ __attribute__((ext_vector_type(8))); typedef float f32x16_ __attribute__((ext_vector_type(16)));
    const int r = lane & 31, hi = lane >> 5;
    const bf16x8_* ap = (const bf16x8_*)(H + (size_t)(row0 + r) * DM + hi * 8);
    const bf16x8_* bp = (const bf16x8_*)(Wf + (size_t)r * DM + hi * 8);
    f32x16_ acc = {};
#pragma unroll 8
    for (int ks = 0; ks < DM / 16; ++ks) acc = __builtin_amdgcn_mfma_f32_32x32x16_bf16(bp[2 * ks], ap[2 * ks], acc, 0, 0, 0);
    const int tok = row0 + r; float* lp = lf + ((size_t)(tok >> 11) * 32) * 2048 + (tok & 2047);
#pragma unroll
    for (int g = 0; g < 4; ++g) { const f32x4 bias = *(const f32x4*)(bfb + 8 * g + 4 * hi);
#pragma unroll
        for (int i = 0; i < 4; ++i) { const float xx = acc[4 * g + i] + bias[i];
            lp[(size_t)(8 * g + 4 * hi + i) * 2048] = (fminf(xx, 0.f) - log1pf(__expf(-fabsf(xx)))) * 1.4426950408889634f; } }
}

__device__ __forceinline__ int fresh_tid_(int wave_s) { int t = (wave_s << 6) | (int)__builtin_amdgcn_mbcnt_hi(~0u, __builtin_amdgcn_mbcnt_lo(~0u, 0u)); asm volatile("" : "+v"(t)); return t; }
#define fresh_tid() fresh_tid_(wave_s)
#define CAS __attribute__((address_space(4)))
__device__ __forceinline__ const CAS Params* launder(const CAS Params* q) { asm volatile("" : "+s"(q)); return q; }
#define PP (launder(kp0))
#ifndef PROBE_MASK
#define PROBE_MASK 0u
#endif
#if PROBE_MASK
#define STAMP(k) do { const unsigned long long t_ = __builtin_amdgcn_s_memrealtime(); if ((PROBE_MASK >> (k)) & 1u) pr_acc += t_ - pr_prev; pr_prev = t_; } while (0)
#else
#define STAMP(k) do { } while (0)
#endif
__global__ void __launch_bounds__(NWAVES * 64) mega_fwd(Params p_kernarg) {
    const CAS Params* const kp0 = (const CAS Params*)__builtin_amdgcn_kernarg_segment_ptr();
    extern __shared__ __attribute__((aligned(16))) unsigned char lds_raw[];
    cg::grid_group grid = cg::this_grid();
#if PROBE_MASK
    unsigned long long pr_prev = __builtin_amdgcn_s_memrealtime(), pr_acc = 0ull;
#endif
    LAS unsigned char* lds = (LAS unsigned char*)lds_raw;
    const int wave_s = __builtin_amdgcn_readfirstlane(threadIdx.x >> 6);
    if (threadIdx.x < 2) ((volatile LAS unsigned*)(lds + LDS_BARST))[threadIdx.x] = 0u;
    __syncthreads();
    XcdBarrier bar = xcd_barrier_post((unsigned*)(PP->ws + WS_BAR), (volatile LAS unsigned*)(lds + LDS_BARST));
    const int G = gridDim.x, bx = blockIdx.x; const int vcu = (G % 8 == 0) ? (bx % 8) * (G / 8) + bx / 8 : bx;
#define WIN_T(l) ((bf16raw*)(PP->ws + ((l) ? WS_WIN1 : WS_WIN0)))
#define WOUT_T(l) ((bf16raw*)(PP->ws + ((l) ? WS_WOUT1 : WS_WOUT0)))
#define MOD_ ((float*)(PP->ws + WS_MOD))
#define LF_ ((float*)(PP->ws + WS_LOGF))
#define H_ ((bf16raw*)(PP->ws + WS_H))
#define QB_ ((bf16raw*)(PP->ws + WS_Q))

    {
        const int tid = fresh_tid(), lane = tid & 63, wave = __builtin_amdgcn_readfirstlane(tid >> 6);
        LAS float* scr = (LAS float*)(lds + wave * 16384);
        const int NADA = (G >= 96) ? 96 : 0;
        const int NGW = (G - NADA) * NWAVES + NADA * 4;
        const int gw = (bx < NADA) ? ((wave < 4) ? bx * 4 + wave : NGW) : NADA * 4 + (bx - NADA) * NWAVES + wave;
        constexpr int I_IN0 = 16 * (NIN0_REAL / 32), I_IN1 = 16 * (NIN1 / 32), I_OUT = 32 * 32;
        constexpr int NITEMS = I_IN0 + I_OUT;
        for (int it = (gw < NGW ? gw : NITEMS); it < NITEMS; it += NGW) {
            int r = it;
            if (r < I_IN0) { transpose_item(PP->fwin, DM, NIN0_REAL, WIN_T(0), scr, r, lane); continue; } r -= I_IN0;
            transpose_item(PP->fwout, DI, DM, WOUT_T(0), scr, r, lane);
        }
        { v4u* z = (v4u*)(WIN_T(0) + (size_t)NIN0_REAL * DM); const int n16 = (NIN0 - NIN0_REAL) * DM * 2 / 16;
          for (int i = bx * 512 + tid; i < n16; i += G * 512) z[i] = (v4u){0u, 0u, 0u, 0u}; }
        if (bx == 0 && tid < 6) ((unsigned*)(PP->ws + WS_CNT))[16 * tid] = 0u;
        if (bx == 0) {
                       unsigned* kw = (unsigned*)(PP->ws + WS_KMX); for (int i = tid; i < NCHUNK * CHB * NH * 2; i += 512) kw[i] = 0u; }
        __syncthreads();
        for (int it = bx; it < 96; it += G) { const int l = it / 48, cb = it % 48;
            ada_item(PP->c, l ? PP->swada : PP->fwada, l ? PP->sbada : PP->fbada, MOD_ + (size_t)l * NB * 3072, cb, lds, tid); }
    }
    if (PP->ws == nullptr) grid.sync();
    xcd_barrier(bar); STAMP(0);
    const int rows_per_wave = CH / (G * NWAVES);
#define NORM_PHASE(l, ch) do { const int tid = fresh_tid(), lane = tid & 63, wave = __builtin_amdgcn_readfirstlane(tid >> 6); const int lr0 = (vcu * NWAVES + wave) * rows_per_wave; \
        if (l) norm_rows<true>((const void*)(PP->ws + WS_X1B), PP->sng, MOD_ + (size_t)NB * 3072, H_, (ch) * CH + lr0, lr0, rows_per_wave, lane); \
        else norm_rows<false>((const void*)PP->x, PP->fng, MOD_, H_, (ch) * CH + lr0, lr0, rows_per_wave, lane); } while (0)
    NORM_PHASE(0, 0);
    xcd_barrier(bar); STAMP(1);
    auto layer_chunk = [&](auto LC, auto CC) __attribute__((always_inline)) {
        constexpr int l = decltype(LC)::value, ch = decltype(CC)::value;
            {
                if (l == 0) { const int tid = fresh_tid(), lane = tid & 63, wave = __builtin_amdgcn_readfirstlane(tid >> 6);
                    for (int task = vcu * NWAVES + wave; task < CH / 32; task += G * NWAVES) forget_task(H_, WIN_T(0) + (size_t)NIN1 * DM, PP->fbf, LF_, task * 32, lane); }
                pg8::Gemm g{H_, WIN_T(l), CH, NIN1, DM}; pg8::StaticOrder S; S.init(CH, NIN1, G, bx);
                pg8::EpiProj E{QB_, QKVZ_STRIDE, att::C2, LF_, PP->fbf, l ? (unsigned*)nullptr : (unsigned*)(PP->ws + WS_KMX) + ch * CHB * NH * 2};
                pg8::gemm_phase<pg8::EpiProj, pg8::StaticOrder, true, true>(lds, g, S, E, fresh_tid());
            }
            xcd_barrier(bar); STAMP(2 + 3 * (l * NCHUNK + ch));
            {
                const att::bf16* Qp = (const att::bf16*)QB_; const att::bf16* Kp = Qp + QKVZ_STRIDE; const att::bf16* Vp = Kp + QKVZ_STRIDE; const att::bf16* Zp = Vp + QKVZ_STRIDE;
                LAS unsigned* misc = (LAS unsigned*)(lds + att::L_MISC); const int tid = fresh_tid();
                if (tid < 32) { unsigned rank = tid;
                    if (l == 0) { const float* bfp = PP->fbf; const float mine = bfp[tid]; rank = 0; for (int j = 0; j < 32; ++j) { const float o = bfp[j]; rank += (o > mine || (o == mine && j < tid)) ? 1u : 0u; } }
                    misc[32 + rank] = tid; }
                __syncthreads();
                unsigned* counter = (unsigned*)(PP->ws + WS_CNT) + 16 * (l * NCHUNK + ch);
                for (;;) {
                    if (tid == 0) misc[0] = atomicAdd(counter, 1u);
                    __syncthreads();
                    const int it = __builtin_amdgcn_readfirstlane(misc[0]);
                    if (it >= CHB * NH * 2) break;
                    const int it2 = it >> 1, qhi = (it & 1) ? 3 : att::NQB - 1, qlo = (it & 1) ? 0 : 4;
                    const int h = __builtin_amdgcn_readfirstlane(misc[32 + it2 / CHB]), tok0 = (it2 % CHB) * SEQ, rowbase = ((it2 % CHB) * NH + h) * SEQ;
                    if (l == 0) { fox_prep(LF_, (const unsigned*)(PP->ws + WS_KMX) + ((ch * CHB + it2 % CHB) * NH + h) * 2, tok0, h, lds, fresh_tid());
                        att::bh_item<0>(rowbase, qhi, qlo, Qp, Kp, Vp, Zp, (att::bf16*)QB_, (LAS char*)lds, fresh_tid()); }
                    else att::bh_item<1>(rowbase, qhi, qlo, Qp, Kp, Vp, Zp, (att::bf16*)QB_, (LAS char*)lds, fresh_tid());
                }
                asm volatile("s_waitcnt vmcnt(0) lgkmcnt(0)" ::: "memory"); __syncthreads();
                if (l == 0) {
                    constexpr int I_IN1 = 16 * (NIN1 / 32), I_OUT1 = 32 * 32, NB1 = (I_IN1 + I_OUT1) / 8, NBP = NB1 / NCHUNK;
                    unsigned* tq = (unsigned*)(PP->ws + WS_CNT) + 16 * (4 + ch);
                    const int t2 = fresh_tid(), lane2 = t2 & 63, wave2 = __builtin_amdgcn_readfirstlane(t2 >> 6);
                    LAS float* scr2 = (LAS float*)(lds + wave2 * 16384);
                    for (;;) {
                        if (t2 == 0) misc[0] = atomicAdd(tq, 1u);
                        __syncthreads();
                        const int bq = __builtin_amdgcn_readfirstlane(misc[0]);
                        __syncthreads();
                        if (bq >= NBP) break;
                        const int r = (ch * NBP + bq) * 8 + wave2;
                        if (r < I_IN1) transpose_item(PP->swin, DM, NIN1, WIN_T(1), scr2, r, lane2);
                        else transpose_item(PP->swout, DI, DM, WOUT_T(1), scr2, r - I_IN1, lane2);
                    }
                }
            }
            xcd_barrier(bar); STAMP(3 + 3 * (l * NCHUNK + ch));
            {
                pg8::Gemm g{QB_, WOUT_T(l), CH, DM, DI}; pg8::StaticOrder S; S.init(CH, DM, G, bx);
                pg8::EpiRes<(l != 0)> E{l ? (const void*)(PP->ws + WS_X1B) : (const void*)PP->x, (pg8::bf16_t*)(PP->ws + (l ? WS_X2B : WS_X1B)), MOD_ + (size_t)l * NB * 3072 + 2048, ch * CH};
                pg8::gemm_phase<pg8::EpiRes<(l != 0)>, pg8::StaticOrder, true, true, true>(lds, g, S, E, fresh_tid());
            }
            if (ch + 1 < NCHUNK) NORM_PHASE(l, ch + 1);
            else if (l == 0) NORM_PHASE(1, 0);
            xcd_barrier(bar); STAMP(4 + 3 * (l * NCHUNK + ch));
    };
    layer_chunk(std::integral_constant<int, 0>{}, std::integral_constant<int, 0>{});
    layer_chunk(std::integral_constant<int, 0>{}, std::integral_constant<int, 1>{});
    layer_chunk(std::integral_constant<int, 1>{}, std::integral_constant<int, 0>{});
    layer_chunk(std::integral_constant<int, 1>{}, std::integral_constant<int, 1>{});
    { const int tid = fresh_tid(), lane = tid & 63, wave = __builtin_amdgcn_readfirstlane(tid >> 6); const int rpw = MTOK / (G * NWAVES); final_norm_rows((const bf16raw*)(PP->ws + WS_X2B), PP->out, PP->fing, (vcu * NWAVES + wave) * rpw, rpw, lane); }
#if PROBE_MASK
    STAMP(14);
    if (bx == 0 && fresh_tid() == 0) { const unsigned long long t0_ = __builtin_amdgcn_s_memrealtime(); while (__builtin_amdgcn_s_memrealtime() - t0_ < pr_acc) __builtin_amdgcn_s_sleep(16); }
#endif
}

extern "C" void kernel_launch(void* const* d_in, const int* in_sizes, int n_in, void* d_out, int out_size, void* d_ws, size_t ws_size, hipStream_t stream) {
    static int grid = 0;
    if (grid == 0) {
        if (n_in != 14 || in_sizes[0] != MTOK * DM || out_size != MTOK * DM || ws_size < WS_END) { fprintf(stderr, "kernel_launch: unexpected shapes (n_in %d, in0 %d, out %d, ws %zu < %zu); nothing launched\n", n_in, n_in > 0 ? in_sizes[0] : -1, out_size, ws_size, (size_t)WS_END); grid = -1; return; }
        int dev = 0, cus = 0, per_cu = 0;
        if (hipGetDevice(&dev) != hipSuccess || hipDeviceGetAttribute(&cus, hipDeviceAttributeMultiprocessorCount, dev) != hipSuccess) { grid = -1; return; }
        if (hipFuncSetAttribute((const void*)mega_fwd, hipFuncAttributeMaxDynamicSharedMemorySize, LDS_BYTES) != hipSuccess) { fprintf(stderr, "kernel_launch: hipFuncSetAttribute failed\n"); grid = -1; return; }
        if (hipOccupancyMaxActiveBlocksPerMultiprocessor(&per_cu, (const void*)mega_fwd, NWAVES * 64, LDS_BYTES) != hipSuccess || per_cu < 1) { fprintf(stderr, "kernel_launch: occupancy query gave %d\n", per_cu); per_cu = 1; }
        (void)hipGetLastError();
        grid = cus * per_cu;
        if (CH % (grid * NWAVES) != 0 || grid % 8 != 0) { fprintf(stderr, "kernel_launch: grid %d does not divide the row split\n", grid); grid = -1; return; }
    }
    if (grid < 0) return;
    Params p{};
    p.x = (const float*)d_in[0]; p.c = (const float*)d_in[1]; p.fng = (const float*)d_in[2]; p.fwada = (const float*)d_in[3]; p.fbada = (const float*)d_in[4];
    p.fwin = (const float*)d_in[5]; p.fbf = (const float*)d_in[6]; p.fwout = (const float*)d_in[7]; p.sng = (const float*)d_in[8]; p.swada = (const float*)d_in[9];
    p.sbada = (const float*)d_in[10]; p.swin = (const float*)d_in[11]; p.swout = (const float*)d_in[12]; p.fing = (const float*)d_in[13];
    p.out = (float*)d_out; p.ws = (unsigned char*)d_ws;
    if (hipMemsetAsync((unsigned char*)d_ws + WS_BAR, 0, XCD_BAR_WORDS * 4, stream) != hipSuccess) { fprintf(stderr, "kernel_launch: hipMemsetAsync failed\n"); return; }
    void* args[] = {&p};
    hipError_t e = hipLaunchCooperativeKernel((const void*)mega_fwd, dim3(grid), dim3(NWAVES * 64), args, LDS_BYTES, stream);
    if (e != hipSuccess) fprintf(stderr, "kernel_launch: cooperative launch failed: %s (grid %d)\n", hipGetErrorString(e), grid);
}
```

```cpp
#include <hip/hip_runtime.h>
#include <hip/hip_cooperative_groups.h>
#include <hip/hip_bf16.h>
#include <cstdio>
#include <cstdint>
#include <cmath>
#include <type_traits>
namespace cg = cooperative_groups;
namespace pg8 {
#define PG8_LAS __attribute__((address_space(3)))
typedef unsigned short bf16_t;
typedef short bf16x8 __attribute__((ext_vector_type(8)));
typedef float f32x4 __attribute__((ext_vector_type(4)));
typedef unsigned u32x4 __attribute__((ext_vector_type(4)));
constexpr int BM = 256, BK = 64, HALF = 128, HTB = HALF * BK * 2  , STAGE_BYTES = 8 * HTB, NXCD = 8, WGM = 8;

__host__ __device__ __forceinline__ int lds_byte(int r, int c) { const int st = (r >> 4) * 2 + (c >> 5), rr = r & 15, cc = c & 31, ob = rr * 64 + cc * 2; return st * 1024 + (ob ^ (((ob >> 9) & 1) << 5)); }
__host__ __device__ __forceinline__ void stage_rc(int b, int& R, int& C) { const int st = b / 1024, sb = b % 1024, swz = sb ^ (((sb >> 9) & 1) << 5); R = (st >> 1) * 16 + swz / 64; C = (st & 1) * 32 + (swz % 64) / 2; }
__host__ __device__ __forceinline__ int perm32(int rho) { const int n = rho >> 4, i = rho & 15; return 8 * (i >> 2) + 4 * n + (i & 3); }

struct Unit { int pm, pn; };
struct Gemm { const bf16_t* A; const bf16_t* Bt; int M, N, K; };

struct StaticOrder {
    int nM, nN, nwg, G, c;
    __host__ __device__ void init(int M, int N, int G_, int c_) { nM = M / BM; nN = N / BM; nwg = nM * nN; G = G_; c = c_; }
    __host__ __device__ bool next(int i, Unit& u) const {
        const long L = (long)i * G + c; if (L >= nwg) return false;
        int wgid = (int)L; { const int q = nwg / NXCD, r = nwg % NXCD, xcd = wgid % NXCD, off = wgid / NXCD; wgid = (xcd < r ? xcd * (q + 1) : r * (q + 1) + (xcd - r) * q) + off; }
        const int nig = WGM * nN, gid = wgid / nig, fm = gid * WGM, gsz = (nM - fm) < WGM ? (nM - fm) : WGM;
        u.pm = fm + ((wgid % nig) % gsz); u.pn = (wgid % nig) / gsz; return true;
    }
    __device__ __forceinline__ void a_ready(const Unit&) const {}
    __device__ __forceinline__ void done(const Unit&) const {}
};

__device__ __forceinline__ unsigned cvt_pk_bf16(float lo, float hi) { unsigned r; asm volatile("v_cvt_pk_bf16_f32 %0, %1, %2" : "=v"(r) : "v"(lo), "v"(hi)); return r; }
typedef float f32x2 __attribute__((ext_vector_type(2)));
typedef float f32x2 __attribute__((ext_vector_type(2)));
struct EpiProj {
    static constexpr bool PERM = true, AFTER_DRAIN = false;
    bf16_t* O; size_t split_stride; float scale0; float* lf; const float* bf; unsigned* kmx;
    __device__ __forceinline__ void operator()(const f32x4 (&acc)[2][2][4][2], const Unit& u, int wr, int wc, int fr, int fq) const {
        const int t = u.pn >> 3;
        const int row0 = u.pm * BM + wr * 64 + fr;
        if (t < 4) {
            bf16_t* base = O + (size_t)t * split_stride; const float sc = (t == 0) ? scale0 : 1.f;
            const int bl = u.pm >> 3, s0 = (u.pm & 7) * BM + wr * 64 + fr, dcol = (wc & 1) * 32 + 8 * fq;
            float kss[2][8];
#pragma unroll
            for (int bj = 0; bj < 2; ++bj) { const int hd = (u.pn & 7) * 4 + bj * 2 + (wc >> 1); bf16_t* hp = base + ((size_t)(bl * 32 + hd) * 2048 + s0) * 64 + dcol;
#pragma unroll
                for (int ai = 0; ai < 2; ++ai)
#pragma unroll
                    for (int m = 0; m < 4; ++m) { f32x4 v0 = acc[ai][bj][m][0], v1 = acc[ai][bj][m][1]; if (t == 0) { v0 = v0 * sc; v1 = v1 * sc; }
                        u32x4 w; w.x = cvt_pk_bf16(v0[0], v0[1]); w.y = cvt_pk_bf16(v0[2], v0[3]); w.z = cvt_pk_bf16(v1[0], v1[1]); w.w = cvt_pk_bf16(v1[2], v1[3]);
                        *(u32x4*)(hp + (size_t)(ai * HALF + m * 16) * 64) = w;
                        if (t == 1 && kmx) { float ss = 0.f;
#pragma unroll
                            for (int e_ = 0; e_ < 4; ++e_) { const float lo_ = __uint_as_float(w[e_] << 16), hi_ = __uint_as_float(w[e_] & 0xffff0000u); ss += lo_ * lo_ + hi_ * hi_; }
                            kss[bj][ai * 4 + m] = ss; } } }
            if (t == 1 && kmx) {
#pragma unroll
                for (int bj = 0; bj < 2; ++bj) { float mx = 0.f;
#pragma unroll
                    for (int q = 0; q < 8; ++q) { float ss = kss[bj][q]; ss += __shfl_xor(ss, 16); ss += __shfl_xor(ss, 32); mx = fmaxf(mx, ss); }
#pragma unroll
                    for (int o = 1; o < 16; o <<= 1) mx = fmaxf(mx, __shfl_xor(mx, o));
                    if (fr == 0 && fq == 0) atomicMax(kmx + ((bl * 32 + (u.pn & 7) * 4 + bj * 2 + (wc >> 1)) * 2 + (wc & 1)), __float_as_uint(mx)); }
            }
        } else if (wc == 0) {
            f32x4 bv[2];
#pragma unroll
            for (int n = 0; n < 2; ++n) bv[n] = *(const f32x4*)(bf + 8 * fq + 4 * n);
#pragma unroll
            for (int ai = 0; ai < 2; ++ai)
#pragma unroll
                for (int m = 0; m < 4; ++m) { float* rowp = lf + (size_t)(row0 + ai * HALF + m * 16) * 32 + 8 * fq;
#pragma unroll
                    for (int n = 0; n < 2; ++n) { f32x4 v = acc[ai][0][m][n] + bv[n]; f32x4 o;
#pragma unroll
                        for (int e = 0; e < 4; ++e) { const float xx = v[e]; o[e] = (fminf(xx, 0.f) - log1pf(__expf(-fabsf(xx)))) * 1.4426950408889634f; }
                        *(f32x4*)(rowp + 4 * n) = o; } }
        }
    }
};
template <bool BASE_BF>
struct EpiRes {
    static constexpr bool PERM = true, AFTER_DRAIN = false;
    const void* base; bf16_t* outb; const float* gate; int row_off;
    __device__ __forceinline__ void operator()(const f32x4 (&acc)[2][2][4][2], const Unit& u, int wr, int wc, int fr, int fq) const {
        const int col0 = u.pn * BM + wc * 32 + 8 * fq; const int b = (row_off + u.pm * BM) >> 11;
        f32x4 gv[2][2];
#pragma unroll
        for (int bj = 0; bj < 2; ++bj)
#pragma unroll
            for (int n = 0; n < 2; ++n) gv[bj][n] = *(const f32x4*)(gate + (size_t)b * 3072 + col0 + bj * HALF + 4 * n);
#pragma unroll
        for (int ai = 0; ai < 2; ++ai)
#pragma unroll
            for (int m = 0; m < 4; ++m) { const size_t off = (size_t)(row_off + u.pm * BM + wr * 64 + fr + ai * HALF + m * 16) * 1024 + col0;
#pragma unroll
                for (int bj = 0; bj < 2; ++bj) { f32x4 b0, b1;
                    if (BASE_BF) { const u32x4 w = *(const u32x4*)((const bf16_t*)base + off + bj * HALF);
                        b0 = (f32x4){__uint_as_float(w.x << 16), __uint_as_float(w.x & 0xffff0000u), __uint_as_float(w.y << 16), __uint_as_float(w.y & 0xffff0000u)};
                        b1 = (f32x4){__uint_as_float(w.z << 16), __uint_as_float(w.z & 0xffff0000u), __uint_as_float(w.w << 16), __uint_as_float(w.w & 0xffff0000u)}; }
                    else { b0 = *(const f32x4*)((const float*)base + off + bj * HALF); b1 = *(const f32x4*)((const float*)base + off + bj * HALF + 4); }
                    const f32x4 v0 = b0 + gv[bj][0] * acc[ai][bj][m][0], v1 = b1 + gv[bj][1] * acc[ai][bj][m][1];
                    u32x4 o; o.x = cvt_pk_bf16(v0[0], v0[1]); o.y = cvt_pk_bf16(v0[2], v0[3]); o.z = cvt_pk_bf16(v1[0], v1[1]); o.w = cvt_pk_bf16(v1[2], v1[3]);
                    *(u32x4*)(outb + off + bj * HALF) = o; } }
    }
};
template <class Epi, class Sched, bool ALIGN_EPI = false, bool SP2 = false, bool AHM = false>
__device__ __forceinline__ void gemm_phase(PG8_LAS unsigned char* lds, const Gemm g, const Sched& S, const Epi& E, int tid_in) {
    const int tid = tid_in, wid = __builtin_amdgcn_readfirstlane(tid >> 6), lane = tid & 63, wr = wid >> 2, wc = wid & 3, fr = lane & 15, fq = lane >> 4;
    const int K = g.K, nt = K / BK;
    unsigned voffA[2], voffB[2];
#pragma unroll
    for (int i = 0; i < 2; ++i) { int R, C; stage_rc(tid * 16 + i * 8192, R, C); const int Rb = Epi::PERM ? ((R & ~31) + perm32(R & 31)) : R;
        voffA[i] = (unsigned)(R * (AHM ? 64 : K) + C) * 2u; voffB[i] = (unsigned)(Rb * K + C) * 2u; }
    const size_t kstep = (size_t)(BK * 2);
    const size_t hstep = (size_t)HALF * K * 2;
    const size_t tstep = 2 * hstep;
    const size_t kstepA = AHM ? (size_t)2048 * 128 : kstep, hstepA = AHM ? (size_t)HALF * 128 : hstep;
#define PG8_ATILE(pm_) ((const char*)g.A + (AHM ? ((size_t)((pm_) >> 3) * 32 * 2048 + (size_t)((pm_) & 7) * 256) * 128 : (size_t)(pm_) * tstep))
    const unsigned ldsw = (unsigned)wid * 1024u;
    const int aoff = lds_byte(wr * 64 + fr, fq * 8), boff = lds_byte(wc * 32 + fr, fq * 8);
#define PG8_SA(b, h) (((b) * 2 + (h)) * HTB)
#define PG8_SB(b, h) ((4 + (b) * 2 + (h)) * HTB)
#define PG8_STAGE(bufoff, gbase, voff) do { _Pragma("unroll") for (int _i = 0; _i < 2; ++_i) \
        __builtin_amdgcn_global_load_lds((const unsigned*)((const char*)(gbase) + (voff)[_i]), (PG8_LAS unsigned*)(lds + (bufoff) + ldsw + _i * 8192), 16, 0, 0); } while (0)
#define PG8_LDA(dst, b, h) do { _Pragma("unroll") for (int m = 0; m < 4; ++m) _Pragma("unroll") for (int k = 0; k < 2; ++k) dst[m][k] = *(const PG8_LAS bf16x8*)(lds + PG8_SA(b, h) + aoff + m * 2048 + k * 1024); } while (0)
#define PG8_LDB(dst, b, h) do { _Pragma("unroll") for (int n = 0; n < 2; ++n) _Pragma("unroll") for (int k = 0; k < 2; ++k) dst[n][k] = *(const PG8_LAS bf16x8*)(lds + PG8_SB(b, h) + boff + n * 2048 + k * 1024); } while (0)
#define PG8_MMA(ai, bj, At, Bt) do { __builtin_amdgcn_s_setprio(1); _Pragma("unroll") for (int m = 0; m < 4; ++m) _Pragma("unroll") for (int n = 0; n < 2; ++n) _Pragma("unroll") for (int k = 0; k < 2; ++k) \
        acc[ai][bj][m][n] = __builtin_amdgcn_mfma_f32_16x16x32_bf16(Bt[n][k], At[m][k], acc[ai][bj][m][n], 0, 0, 0); __builtin_amdgcn_s_setprio(0); } while (0)
#define PG8_WAIT_V(n) asm volatile("s_waitcnt vmcnt(" #n ")" ::: "memory")
#define PG8_WAIT_L(n) asm volatile("s_waitcnt lgkmcnt(" #n ")" ::: "memory")
#define PG8_BAR __builtin_amdgcn_s_barrier()
#define PG8_SCHED __builtin_amdgcn_sched_barrier(0)
    Unit cur, nxt; int ui = 0;
    if (!S.next(0, cur)) return;
    f32x4 acc[2][2][4][2];
#pragma unroll
    for (int a = 0; a < 2; ++a)
#pragma unroll
        for (int b = 0; b < 2; ++b)
#pragma unroll
            for (int m = 0; m < 4; ++m)
#pragma unroll
                for (int n = 0; n < 2; ++n) acc[a][b][m][n] = (f32x4){0.f, 0.f, 0.f, 0.f};
    bf16x8 At[4][2], B0[2][2], B1[2][2];
    const char* cA = PG8_ATILE(cur.pm); const char* cB = (const char*)g.Bt + (size_t)cur.pn * tstep;
    S.a_ready(cur);
    if constexpr (SP2) {
        PG8_STAGE(PG8_SB(0, 0), cB, voffB); PG8_STAGE(PG8_SB(0, 1), cB + hstep, voffB); PG8_STAGE(PG8_SA(0, 0), cA, voffA); PG8_STAGE(PG8_SA(0, 1), cA + hstepA, voffA);
        if (wr == 1) PG8_BAR;
        PG8_WAIT_V(2); PG8_BAR;
        PG8_STAGE(PG8_SB(1, 0), cB + kstep, voffB); PG8_STAGE(PG8_SA(1, 0), cA + kstepA, voffA); PG8_STAGE(PG8_SB(1, 1), cB + hstep + kstep, voffB);
        PG8_WAIT_V(6); PG8_BAR;
    } else {
        PG8_STAGE(PG8_SB(0, 0), cB, voffB); PG8_STAGE(PG8_SA(0, 0), cA, voffA); PG8_STAGE(PG8_SB(0, 1), cB + hstep, voffB); PG8_STAGE(PG8_SA(0, 1), cA + hstepA, voffA);
        if (wr == 1) PG8_BAR;
        PG8_WAIT_V(4); PG8_BAR;
        PG8_STAGE(PG8_SB(1, 0), cB + kstep, voffB); PG8_STAGE(PG8_SA(1, 0), cA + kstepA, voffA); PG8_STAGE(PG8_SB(1, 1), cB + hstep + kstep, voffB);
        PG8_WAIT_V(6); PG8_BAR;
    }
    for (;;) {
        const bool has_next = S.next(ui + 1, nxt);
        const char* nA = has_next ? PG8_ATILE(nxt.pm) : cA; const char* nB = has_next ? (const char*)g.Bt + (size_t)nxt.pn * tstep : cB;
        for (int t = 0; t < nt; t += 2) {
            const bool last = (t == nt - 2);
            const char* a1 = cA + (size_t)(t + 1) * kstepA;
            const char* a2 = last ? nA : cA + (size_t)(t + 2) * kstepA; const char* b2 = last ? nB : cB + (size_t)(t + 2) * kstep;
            const char* a3 = a2 + kstepA; const char* b3 = b2 + kstep;
            if (last && has_next) S.a_ready(nxt);
            if constexpr (SP2) {
            PG8_LDB(B0, 0, 0); PG8_LDB(B1, 0, 1); PG8_SCHED; PG8_LDA(At, 0, 0); PG8_STAGE(PG8_SA(1, 1), a1 + hstepA, voffA);
            PG8_WAIT_V(8); PG8_WAIT_L(0); PG8_BAR; PG8_MMA(0, 0, At, B0); PG8_MMA(0, 1, At, B1); PG8_BAR; PG8_SCHED;
            PG8_LDA(At, 0, 1); PG8_STAGE(PG8_SB(0, 0), b2, voffB); PG8_STAGE(PG8_SB(0, 1), b2 + hstep, voffB); PG8_STAGE(PG8_SA(0, 0), a2, voffA);
            PG8_WAIT_V(8); PG8_WAIT_L(0); PG8_BAR; PG8_MMA(1, 0, At, B0); PG8_MMA(1, 1, At, B1); PG8_BAR; PG8_SCHED;
            PG8_LDB(B0, 1, 0); PG8_LDB(B1, 1, 1); PG8_SCHED; PG8_LDA(At, 1, 0); PG8_STAGE(PG8_SA(0, 1), a2 + hstepA, voffA);
            PG8_WAIT_V(8); PG8_WAIT_L(0); PG8_BAR; PG8_MMA(0, 0, At, B0); PG8_MMA(0, 1, At, B1); PG8_BAR; PG8_SCHED;
            PG8_LDA(At, 1, 1); PG8_STAGE(PG8_SB(1, 0), b3, voffB); PG8_STAGE(PG8_SB(1, 1), b3 + hstep, voffB); PG8_STAGE(PG8_SA(1, 0), a3, voffA);
            PG8_WAIT_V(8); PG8_WAIT_L(0); PG8_BAR; PG8_MMA(1, 0, At, B0); PG8_MMA(1, 1, At, B1); PG8_BAR; PG8_SCHED;
            } else {
            PG8_LDB(B0, 0, 0); PG8_SCHED; PG8_LDA(At, 0, 0); PG8_STAGE(PG8_SA(1, 1), a1 + hstepA, voffA);
            PG8_WAIT_L(8); PG8_BAR; PG8_WAIT_L(0); PG8_MMA(0, 0, At, B0); PG8_BAR; PG8_SCHED;
            PG8_LDB(B1, 0, 1); PG8_STAGE(PG8_SB(0, 0), b2, voffB);
            PG8_BAR; PG8_WAIT_L(0); PG8_MMA(0, 1, At, B1); PG8_BAR;
            PG8_LDA(At, 0, 1); PG8_STAGE(PG8_SA(0, 0), a2, voffA);
            PG8_BAR; PG8_WAIT_L(0); PG8_MMA(1, 0, At, B0); PG8_BAR; PG8_SCHED;
            PG8_STAGE(PG8_SB(0, 1), b2 + hstep, voffB);
            PG8_WAIT_V(6); PG8_BAR; PG8_MMA(1, 1, At, B1); PG8_BAR;
            PG8_LDB(B0, 1, 0); PG8_SCHED; PG8_LDA(At, 1, 0); PG8_STAGE(PG8_SA(0, 1), a2 + hstepA, voffA);
            PG8_WAIT_L(8); PG8_BAR; PG8_WAIT_L(0); PG8_MMA(0, 0, At, B0); PG8_BAR; PG8_SCHED;
            PG8_LDB(B1, 1, 1); PG8_STAGE(PG8_SB(1, 0), b3, voffB);
            PG8_BAR; PG8_WAIT_L(0); PG8_MMA(0, 1, At, B1); PG8_BAR;
            PG8_LDA(At, 1, 1); PG8_STAGE(PG8_SA(1, 0), a3, voffA);
            PG8_BAR; PG8_WAIT_L(0); PG8_MMA(1, 0, At, B0); PG8_BAR; PG8_SCHED;
            PG8_STAGE(PG8_SB(1, 1), b3 + hstep, voffB);
            PG8_WAIT_V(6); PG8_BAR; PG8_MMA(1, 1, At, B1); PG8_BAR;
            }
        }
        if constexpr (ALIGN_EPI) { if (wr == 0) PG8_BAR; }
        if constexpr (!Epi::AFTER_DRAIN) { E(acc, cur, wr, wc, fr, fq); S.done(cur); }
        if (!has_next) break;
#pragma unroll
        for (int a = 0; a < 2; ++a)
#pragma unroll
            for (int b = 0; b < 2; ++b)
#pragma unroll
                for (int m = 0; m < 4; ++m)
#pragma unroll
                    for (int n = 0; n < 2; ++n) acc[a][b][m][n] = (f32x4){0.f, 0.f, 0.f, 0.f};
        cur = nxt; cA = nA; cB = nB; ++ui;
        if constexpr (ALIGN_EPI) { if (wr == 1) PG8_BAR; }
    }
    PG8_WAIT_V(0);
    if constexpr (!ALIGN_EPI) { if (wr == 0) PG8_BAR; }
    PG8_BAR;
    if constexpr (Epi::AFTER_DRAIN) { E.fused(acc, cur, wr, wc, fr, fq, lds, wid, lane); S.done(cur); }
#undef PG8_SA
#undef PG8_ATILE
#undef PG8_SB
#undef PG8_STAGE
#undef PG8_LDA
#undef PG8_LDB
#undef PG8_MMA
#undef PG8_WAIT_V
#undef PG8_WAIT_L
#undef PG8_BAR
#undef PG8_SCHED
}
}
namespace att {
typedef __hip_bfloat16 bf16;
typedef __attribute__((ext_vector_type(8))) short bf16x8;
typedef __attribute__((ext_vector_type(4))) short s16x4;
typedef __attribute__((ext_vector_type(16))) float f32x16;
typedef __attribute__((ext_vector_type(4))) float f32x4;
typedef __attribute__((ext_vector_type(4))) unsigned u32x4;
typedef __attribute__((ext_vector_type(2))) unsigned u32x2;
#define ALAS __attribute__((address_space(3)))
constexpr int PITCH = 64, SEQ = 2048, D = 64, QB = 256, KVB = 64, NQB = SEQ / QB;
constexpr int SLOTB = 16384, NSLOT = 6;
constexpr int L_CUM = NSLOT * SLOTB, L_WSF = L_CUM + SEQ * 4, L_MISC = L_WSF + 8 * 256, L_OST = L_MISC + 256, L_END = L_OST + 8 * 4096;
constexpr float C2 = 0.125f * 1.4426950408889634f;
__device__ __forceinline__ int crow(int r, int hi) { return (r & 3) + 8 * (r >> 2) + 4 * hi; }
__device__ __forceinline__ void glds16(const void* gsrc, unsigned lds_dst) { unsigned keep;
  asm volatile("s_mov_b32 %0, m0\n\ts_mov_b32 m0, %2\n\ts_nop 0\n\tglobal_load_lds_dwordx4 %1, off\n\ts_mov_b32 m0, %0" : "=&s"(keep) : "v"(gsrc), "s"(lds_dst) : "memory"); }
typedef float f32x2_t __attribute__((ext_vector_type(2))); typedef __bf16 bf16x2_t __attribute__((ext_vector_type(2)));
__device__ __forceinline__ unsigned cvtpk(float lo, float hi) { f32x2_t v = {lo, hi}; bf16x2_t b = __builtin_convertvector(v, bf16x2_t); return __builtin_bit_cast(unsigned, b); }
typedef short v4i16_t __attribute__((ext_vector_type(4)));
__device__ __forceinline__ s16x4 vtr(const ALAS char* p) { return __builtin_bit_cast(s16x4, __builtin_amdgcn_ds_read_tr16_b64_v4i16((ALAS v4i16_t*)p)); }
__device__ __forceinline__ float swap_sum(float v) { auto rr = __builtin_amdgcn_permlane32_swap(__float_as_uint(v), __float_as_uint(v), false, false); return __uint_as_float(rr[0]) + __uint_as_float(rr[1]); }
__device__ __forceinline__ float swap_max(float v) { auto rr = __builtin_amdgcn_permlane32_swap(__float_as_uint(v), __float_as_uint(v), false, false); return fmaxf(__uint_as_float(rr[0]), __uint_as_float(rr[1])); }
#define AWAIT_BAR(N) asm volatile("s_waitcnt vmcnt(" #N ") lgkmcnt(0)\n\ts_barrier" ::: "memory")

struct St { f32x16 o0, o1; float mhat, l, R; };
#define SCHED_FENCE() __builtin_amdgcn_sched_barrier(0)

__device__ __forceinline__ void k_frags(bf16x8 (&kf)[4], const ALAS char* kph, int kx) {
  asm volatile("" : "+v"(kx));
#pragma unroll
  for (int d0 = 0; d0 < 4; ++d0) kf[d0] = *(const ALAS bf16x8*)(kph + (kx ^ (d0 << 5)));
}
__device__ __forceinline__ void qk_half(f32x16& p, const bf16x8 (&kf)[4], const bf16x8* qr, const f32x16& c) {
  p = __builtin_amdgcn_mfma_f32_32x32x16_bf16(kf[0], qr[0], c, 0, 0, 0);
#pragma unroll
  for (int d0 = 1; d0 < 4; ++d0) p = __builtin_amdgcn_mfma_f32_32x32x16_bf16(kf[d0], qr[d0], p, 0, 0, 0);
}
struct VF { bf16x8 v[2][2]; };
__device__ __forceinline__ void v_frags(VF& f, const ALAS char* vph) {
#pragma unroll
  for (int k2 = 0; k2 < 2; ++k2) {
    const s16x4 a0 = vtr(vph + k2 * 2048), a1 = vtr(vph + k2 * 2048 + 1024), b0 = vtr(vph + 512 + k2 * 2048), b1 = vtr(vph + 512 + k2 * 2048 + 1024);
    f.v[k2][0] = (bf16x8){a0[0], a0[1], a0[2], a0[3], a1[0], a1[1], a1[2], a1[3]};
    f.v[k2][1] = (bf16x8){b0[0], b0[1], b0[2], b0[3], b1[0], b1[1], b1[2], b1[3]};
  }
}
__device__ __forceinline__ void pv_half(St& s, const VF& f, const f32x16& p) {
  const u32x4 pw0 = (u32x4){cvtpk(p[0], p[1]), cvtpk(p[2], p[3]), cvtpk(p[4], p[5]), cvtpk(p[6], p[7])};
  const u32x4 pw1 = (u32x4){cvtpk(p[8], p[9]), cvtpk(p[10], p[11]), cvtpk(p[12], p[13]), cvtpk(p[14], p[15])};
  s.o0 = __builtin_amdgcn_mfma_f32_32x32x16_bf16(__builtin_bit_cast(bf16x8, pw0), f.v[0][0], s.o0, 0, 0, 0);
  s.o1 = __builtin_amdgcn_mfma_f32_32x32x16_bf16(__builtin_bit_cast(bf16x8, pw0), f.v[0][1], s.o1, 0, 0, 0);
  s.o0 = __builtin_amdgcn_mfma_f32_32x32x16_bf16(__builtin_bit_cast(bf16x8, pw1), f.v[1][0], s.o0, 0, 0, 0);
  s.o1 = __builtin_amdgcn_mfma_f32_32x32x16_bf16(__builtin_bit_cast(bf16x8, pw1), f.v[1][1], s.o1, 0, 0, 0);
}

template <bool STRICT>
__device__ __forceinline__ void tri_mask(f32x16& P, int rr, int hi) {
  float t = ((float)(rr - 4 * hi) + (STRICT ? -0.5f : 0.5f)) * 0x1p100f;
#pragma unroll
  for (int r = 0; r < 16; ++r) { P[r] = fminf(P[r], t); t -= ((r & 3) == 3) ? 5.0f * 0x1p100f : 0x1p100f; }
}

template <bool TRI, bool FIRST>
__device__ __forceinline__ float fox_soft(St& s, f32x16& p, int rr, int hi, int r32, ALAS float* wsf) {
  if (TRI) tri_mask<false>(p, rr, hi);
  float a = fmaxf(p[0], p[1]);
#pragma unroll
  for (int r = 2; r < 16; ++r) a = fmaxf(a, p[r]);
  const float rm = swap_max(a);
  float dl = 0.f;
  if (FIRST) {
    dl = rm; s.mhat += rm;
#pragma unroll
    for (int r = 0; r < 16; ++r) p[r] -= rm;
  } else if (__any(rm > 8.0f)) {
    dl = fmaxf(rm, 0.f); s.mhat += dl;
#pragma unroll
    for (int r = 0; r < 16; ++r) p[r] -= dl;
    const float f = __builtin_amdgcn_exp2f(-dl); s.l *= f;
    if (hi == 0) wsf[r32] = f;
    asm volatile("s_waitcnt lgkmcnt(0)" ::: "memory");
#pragma unroll
    for (int r = 0; r < 16; ++r) { const float fr_ = wsf[crow(r, hi)]; s.o0[r] *= fr_; s.o1[r] *= fr_; }
    asm volatile("s_waitcnt lgkmcnt(0)" ::: "memory");
  }
  float sum = 0.f;
#pragma unroll
  for (int r = 0; r < 16; ++r) { p[r] = __builtin_amdgcn_exp2f(p[r]); sum += p[r]; }
  s.l += sum;
  return dl;
}
template <bool DIAG>
__device__ __forceinline__ void fox_tile(St& s, const ALAS char* kp, int kx, const ALAS char* vp, const bf16x8* qr, const ALAS float* ck, float cq2, int qrel, int hi, int r32, ALAS float* wsf) {
  const float cb = cq2 - s.mhat;
  const bool lowrows = DIAG && (qrel < 32);
  f32x16 p0, p1; bf16x8 kf0[4], kf1[4];
  k_frags(kf0, kp, kx);
  if (!lowrows) {
    k_frags(kf1, kp + 4096, kx);
#pragma unroll
    for (int g = 0; g < 4; ++g) { const f32x4 b = *(const ALAS f32x4*)(ck + 32 + 8 * g + 4 * hi);
#pragma unroll
      for (int i = 0; i < 4; ++i) p1[4 * g + i] = cb - b[i]; }
    qk_half(p1, kf1, qr, p1);
  }
#pragma unroll
  for (int g = 0; g < 4; ++g) { const f32x4 a = *(const ALAS f32x4*)(ck + 8 * g + 4 * hi);
#pragma unroll
    for (int i = 0; i < 4; ++i) p0[4 * g + i] = cb - a[i]; }
  qk_half(p0, kf0, qr, p0);
  SCHED_FENCE();
  VF vf;
  if (!lowrows) {
    v_frags(vf, vp + 4096);
    const float dl = DIAG ? fox_soft<true, true>(s, p1, qrel - 32, hi, r32, wsf) : fox_soft<false, false>(s, p1, 0, hi, r32, wsf);
    SCHED_FENCE();
    pv_half(s, vf, p1);
    if (DIAG || __any(dl != 0.f)) {
#pragma unroll
      for (int r = 0; r < 16; ++r) p0[r] -= dl;
    }
    SCHED_FENCE();
    v_frags(vf, vp);
    fox_soft<false, false>(s, p0, 0, hi, r32, wsf);
  } else {
    v_frags(vf, vp);
    fox_soft<true, true>(s, p0, qrel, hi, r32, wsf);
  }
  SCHED_FENCE();
  pv_half(s, vf, p0);
}

template <bool TRI>
__device__ __forceinline__ void sb_half(f32x16& P, float& Y, int rr, int hi) {
  if (TRI) tri_mask<true>(P, rr, hi);
#pragma unroll
  for (int r = 0; r < 16; ++r) { const float e = __builtin_amdgcn_exp2f(P[r]); P[r] = __builtin_amdgcn_rcpf(1.0f + e); }
#pragma unroll
  for (int g = 3; g >= 0; --g) {
    const float k0 = P[4 * g], k1 = P[4 * g + 1], k2 = P[4 * g + 2], k3 = P[4 * g + 3];
    const float t1 = k3 * k2, t0 = t1 * k1, G = t0 * k0;
    auto rr_ = __builtin_amdgcn_permlane32_swap(__float_as_uint(G), __float_as_uint(G), false, false);
    const float Go = __uint_as_float(rr_[0]), Ge = __uint_as_float(rr_[1]);
    const float Y1 = Y * Ge, Y2 = Y1 * Go;
    const float X = hi ? Y : Y1, XG = hi ? Y1 : Y2;
    const float pe2 = X * k3, pe1 = X * t1, pe0 = X * t0;
    P[4 * g + 3] = X - pe2; P[4 * g + 2] = pe2 - pe1; P[4 * g + 1] = pe1 - pe0; P[4 * g] = pe0 - XG;
    Y = Y2;
  }
}
template <bool DIAG>
__device__ __forceinline__ void sb_tile(St& s, const ALAS char* kp, int kx, const ALAS char* vp, const bf16x8* qr, int qrel, int hi) {
  const bool lowrows = DIAG && (qrel < 32);
  f32x16 p0, p1; bf16x8 kf0[4], kf1[4]; const f32x16 z = {};
  k_frags(kf0, kp, kx);
  if (!lowrows) { k_frags(kf1, kp + 4096, kx); qk_half(p1, kf1, qr, z); }
  qk_half(p0, kf0, qr, z);
  SCHED_FENCE();
  VF vf; float Y = s.R;
  if (!lowrows) {
    v_frags(vf, vp + 4096);
    if (DIAG) sb_half<true>(p1, Y, qrel - 32, hi); else sb_half<false>(p1, Y, 0, hi);
    SCHED_FENCE();
    pv_half(s, vf, p1);
    SCHED_FENCE();
    v_frags(vf, vp);
    sb_half<false>(p0, Y, 0, hi);
  } else {
    v_frags(vf, vp);
    sb_half<true>(p0, Y, qrel, hi);
  }
  SCHED_FENCE();
  pv_half(s, vf, p0);
  s.R = Y;
}

template <int MODE>
__device__ __forceinline__ void bh_item(int rowbase, int qb_hi, int qb_lo, const bf16* Q, const bf16* K, const bf16* V, const bf16* Z, bf16* O, ALAS char* shm3, int tid_in) {
  const int tid = tid_in, lane = tid & 63, r32 = lane & 31, hi = lane >> 5; const int wid = __builtin_amdgcn_readfirstlane(tid >> 6);
  const int pr = wid >> 1, w2 = (wid ^ (wid >> 2)) & 1, wrow = 64 * pr + 32 * w2;
  const bf16* Kh = K + (size_t)rowbase * PITCH; const bf16* Vh = V + (size_t)rowbase * PITCH;
  const unsigned lds0 = (unsigned)(uintptr_t)shm3;
  ALAS float* wsf = (ALAS float*)(shm3 + L_WSF) + wid * 64;
  const ALAS float* cum = (const ALAS float*)(shm3 + L_CUM);
  ALAS unsigned* misc = (ALAS unsigned*)(shm3 + L_MISC);
  const bf16* ksrc = Kh + (size_t)(8 * wid + (lane >> 3)) * PITCH + (((lane & 7) ^ (((8 * wid + (lane >> 3)) >> 1) & 7)) * 8);
  const bf16* vsrc = Vh + (size_t)(8 * wid + ((lane & 31) >> 2)) * PITCH + (lane >> 5) * 32 + (lane & 3) * 8;
  const unsigned kdst = lds0 + wid * 1024, vdst = lds0 + 8192 + wid * 1024;
#define DMA_KV(jt) do { const int sl_ = (jt) % NSLOT; glds16(ksrc + (size_t)(jt) * KVB * PITCH, (unsigned)__builtin_amdgcn_readfirstlane(kdst + sl_ * SLOTB)); \
                        glds16(vsrc + (size_t)(jt) * KVB * PITCH, (unsigned)__builtin_amdgcn_readfirstlane(vdst + sl_ * SLOTB)); } while (0)
#define ISSUE_UNIT(qb_, QR, NDMA) do { const int nb0_ = 4 * (qb_); const int tlo_ = (lo >= nb0_ - 1) ? (nb0_ > 0 ? nb0_ - 1 : 0) : nb0_ - 2; NDMA = 0; \
    for (int j_ = nb0_ + 3; j_ >= tlo_; --j_) if (j_ < lo || j_ > lo + 5) { DMA_KV(j_); ++NDMA; } \
    lo = tlo_; \
    const bf16* Qw_ = Q + (size_t)(rowbase + (qb_) * QB + wrow) * PITCH; \
    _Pragma("unroll") for (int d0 = 0; d0 < 4; ++d0) QR[d0] = *(const bf16x8*)(Qw_ + (size_t)r32 * PITCH + d0 * 16 + hi * 8); } while (0)
#define LOAD_Z(qb_, ZZ) do { const bf16* Zw_ = Z + (size_t)(rowbase + (qb_) * QB + wrow) * PITCH; \
    _Pragma("unroll") for (int i_ = 0; i_ < 4; ++i_) ZZ[i_] = *(const u32x4*)(Zw_ + (size_t)(i_ * 8 + (lane >> 3)) * PITCH + (lane & 7) * 8); } while (0)
  const ALAS char* kp0 = shm3 + r32 * 128;
  const int kx = ((hi ^ (r32 >> 1)) & 7) << 4;
  const ALAS char* vp0 = shm3 + 8192 + ((lane >> 4) & 1) * 32 + (lane & 3) * 8 + (4 * hi + ((lane & 15) >> 2)) * 64;
  const int qrel = w2 * 32 + r32;
  bf16x8 qr[4]; int lo = 1 << 20, ndma = 0;
  ISSUE_UNIT(qb_hi, qr, ndma);
  for (int qb = qb_hi; qb >= qb_lo; --qb) {
    const int q0 = qb * QB, jb0 = 4 * qb, jd = jb0 + pr;
    AWAIT_BAR(0);
    {
      const bf16* Zw_ = Z + (size_t)(rowbase + q0 + wrow) * PITCH + (size_t)lane * 8;
      const unsigned zdst = (unsigned)__builtin_amdgcn_readfirstlane(lds0 + L_OST + wid * 4096);
#pragma unroll
      for (int i_ = 0; i_ < 4; ++i_) glds16(Zw_ + (size_t)i_ * 8 * PITCH, zdst + i_ * 1024);
    }
    St s; s.o0 = f32x16{}; s.o1 = f32x16{}; s.mhat = 0.f; s.l = 0.f; s.R = 1.0f;
    float cq2 = 0.f, qkb = 0.f;
    if (MODE == 0) {
      cq2 = cum[q0 + wrow + r32];
      float n2l = 0.f, n2h = 0.f;
#pragma unroll
      for (int d0 = 0; d0 < 4; ++d0)
#pragma unroll
        for (int e = 0; e < 8; ++e) { const float v = __uint_as_float(((unsigned)(unsigned short)qr[d0][e]) << 16); if (d0 < 2) n2l += v * v; else n2h += v * v; }
      qkb = (sqrtf(swap_sum(n2l)) * __uint_as_float(misc[1]) + sqrtf(swap_sum(n2h)) * __uint_as_float(misc[2])) * 1.0001f;
    }
    bool done = false;
    const int NSTEP = jb0 + 4;
    for (int i = 0; i < NSTEP; ++i) {
      const int jt = jd - i, pre = jb0 - i - 2;
      const bool issued = (pre >= 0 && pre < lo);
      if (issued) { DMA_KV(pre); lo = pre; }
      if (!done) {
        if (jt < 0) done = true;
        else {
          const int sl = jt % NSLOT;
          const ALAS char* kp = kp0 + sl * SLOTB; const ALAS char* vp = vp0 + sl * SLOTB;
          if (MODE == 0) {
            if (i == 0) fox_tile<true>(s, kp, kx, vp, qr, cum + 64 * jt, cq2, qrel, hi, r32, wsf);
            else fox_tile<false>(s, kp, kx, vp, qr, cum + 64 * jt, cq2, qrel, hi, r32, wsf);
            if (jt == 0) done = true;
            else { const float cprev = cum[64 * jt - 1]; done = __all((11.0f + qkb + cq2 - cprev - s.mhat) < -32.0f) != 0; }
          } else {
            if (i == 0) sb_tile<true>(s, kp, kx, vp, qr, qrel, hi);
            else sb_tile<false>(s, kp, kx, vp, qr, qrel, hi);
            if (jt == 0) done = true;
            else done = __all(s.R < 0x1p-40f) != 0;
          }
        }
      }
      if (lane == 0) misc[8 + 8 * (i & 1) + wid] = done ? 1u : 0u;
      if (issued) AWAIT_BAR(2); else AWAIT_BAR(0);
      const u32x4 f0 = *(const ALAS u32x4*)(misc + 8 + 8 * (i & 1)), f1 = *(const ALAS u32x4*)(misc + 12 + 8 * (i & 1));
      const unsigned alld = (f0[0] & f0[1] & f0[2] & f0[3]) & (f1[0] & f1[1] & f1[2] & f1[3]);
      if (__builtin_amdgcn_readfirstlane(alld)) break;
    }
    if (qb > qb_lo) ISSUE_UNIT(qb - 1, qr, ndma);
    if (MODE == 0) {
      const float lt = swap_sum(s.l); const float inv = __builtin_amdgcn_rcpf(lt);
      if (hi == 0) wsf[r32] = inv;
      asm volatile("s_waitcnt lgkmcnt(0)" ::: "memory");
#pragma unroll
      for (int r = 0; r < 16; ++r) { const float f = wsf[crow(r, hi)]; s.o0[r] *= f; s.o1[r] *= f; }
    }
    ALAS float* stg = (ALAS float*)(shm3 + L_OST + wid * 4096);
    u32x4 zz[4];
#pragma unroll
    for (int i_ = 0; i_ < 4; ++i_) zz[i_] = *(const ALAS u32x4*)(shm3 + L_OST + wid * 4096 + i_ * 1024 + lane * 16);
    asm volatile("s_waitcnt lgkmcnt(0)" ::: "memory");
    bf16* Ow = O + (size_t)(rowbase + q0 + wrow) * PITCH;
#pragma unroll
    for (int ps = 0; ps < 2; ++ps) {
#pragma unroll
      for (int r8 = 0; r8 < 8; ++r8) { const int r = ps * 8 + r8; const int orow = crow(r8, hi); stg[orow * 64 + r32] = s.o0[r]; stg[orow * 64 + 32 + r32] = s.o1[r]; }
      asm volatile("s_waitcnt lgkmcnt(0)" ::: "memory");
#pragma unroll
      for (int i2 = 0; i2 < 2; ++i2) {
        const int row = i2 * 8 + (lane >> 3), ch = lane & 7, i = ps * 2 + i2;
        const f32x4 a = *(const ALAS f32x4*)(stg + row * 64 + ch * 8), b = *(const ALAS f32x4*)(stg + row * 64 + ch * 8 + 4);
        float ov[8] = {a[0], a[1], a[2], a[3], b[0], b[1], b[2], b[3]};
        unsigned w[4];
#pragma unroll
        for (int e = 0; e < 4; ++e) {
          const float z0 = __uint_as_float(zz[i][e] << 16), z1 = __uint_as_float(zz[i][e] & 0xffff0000u);
          const float g0 = z0 * __builtin_amdgcn_rcpf(1.0f + __builtin_amdgcn_exp2f(-1.4426950408889634f * z0));
          const float g1 = z1 * __builtin_amdgcn_rcpf(1.0f + __builtin_amdgcn_exp2f(-1.4426950408889634f * z1));
          w[e] = cvtpk(ov[2 * e] * g0, ov[2 * e + 1] * g1);
        }
        *(u32x4*)(Ow + (size_t)(ps * 16 + row) * PITCH + ch * 8) = (u32x4){w[0], w[1], w[2], w[3]};
      }
      asm volatile("s_waitcnt lgkmcnt(0)" ::: "memory");
    }
  }
  asm volatile("s_waitcnt vmcnt(0)" ::: "memory");
#undef DMA_KV
#undef ISSUE_UNIT
#undef LOAD_Z
}
}
constexpr int NWAVES = 8;
constexpr int DM = 1024, NB = 32, SEQ = 2048, MTOK = NB * SEQ, DI = 2048, NH = 32;
constexpr int NCHUNK = 2, CH = MTOK / NCHUNK, CHB = NB / NCHUNK;
constexpr int NIN0 = 8448, NIN0_REAL = 8224, NIN1 = 8192;
constexpr float NORM_EPS = 1e-6f;
constexpr size_t MiB = 1u << 20;
constexpr size_t WS_WIN0 = 0, WS_WIN1 = 17 * MiB, WS_WOUT0 = 33 * MiB, WS_WOUT1 = 37 * MiB, WS_MOD = 41 * MiB, WS_LOGF = 42 * MiB, WS_H = 46 * MiB, WS_Q = 110 * MiB;
constexpr size_t WS_CNT = WS_MOD + 0xE0000;
constexpr size_t WS_KMX = WS_MOD + 0xE8000;
constexpr size_t WS_BAR = WS_MOD + 0xE1000;
constexpr int LDS_BARST = 147200;
constexpr size_t QKVZ_STRIDE = (size_t)CH * DI;
constexpr size_t WS_X1B = WS_Q + 4 * QKVZ_STRIDE * 2, WS_X2B = WS_X1B + (size_t)MTOK * DM * 2;
constexpr size_t WS_END = WS_X2B + (size_t)MTOK * DM * 2;
static_assert((size_t)NIN0 * DM * 2 <= WS_WIN1 && (size_t)CH * 32 * 4 <= WS_H - WS_LOGF && (size_t)CH * DM * 2 <= WS_Q - WS_H, "d_ws map");
constexpr int RING_BYTES = 131072, LDS_BYTES = 147456;
static_assert(att::L_END <= LDS_BYTES, "attention LDS map");
#define GAS __attribute__((address_space(1)))
#define LAS __attribute__((address_space(3)))
typedef unsigned short bf16raw;
typedef unsigned v4u __attribute__((ext_vector_type(4)));
typedef float f32x4 __attribute__((ext_vector_type(4)));
#define LDS_WAIT() asm volatile("s_waitcnt lgkmcnt(0)" ::: "memory")
__device__ __forceinline__ unsigned f2bf(float f) { unsigned u = __builtin_bit_cast(unsigned, f); return (u + 0x7fffu + ((u >> 16) & 1u)) >> 16; }
__device__ __forceinline__ unsigned pk2(float lo, float hi) { return f2bf(lo) | (f2bf(hi) << 16); }
__device__ __forceinline__ float wave_sum(float v) {
#pragma unroll
    for (int o = 1; o < 64; o <<= 1) v += __shfl_xor(v, o);
    return v;
}
struct Params { const float *x, *c, *fng, *fwada, *fbada, *fwin, *fbf, *fwout, *sng, *swada, *sbada, *swin, *swout, *fing; float* out; unsigned char* ws; };

__device__ __forceinline__ void transpose_item(const float* W, int K, int N, bf16raw* WT, LAS float* scr, int item, int lane) {
    const int nblk = N / 32, kb = item / nblk, nb = item % nblk, k0 = 64 * kb, n0 = 32 * nb;
#pragma unroll 8
    for (int i = 0; i < 32; ++i) { const int kk = 2 * i + (lane >> 5); scr[kk * 33 + (lane & 31)] = W[(size_t)(k0 + kk) * N + n0 + (lane & 31)]; }
    LDS_WAIT(); asm volatile("" ::: "memory");
    const int c = lane & 7;
#pragma unroll
    for (int j = 0; j < 4; ++j) { const int n = (lane >> 3) + 8 * j; const LAS float* s = scr + (8 * c) * 33 + n;
        v4u o; o.x = pk2(s[0 * 33], s[1 * 33]); o.y = pk2(s[2 * 33], s[3 * 33]); o.z = pk2(s[4 * 33], s[5 * 33]); o.w = pk2(s[6 * 33], s[7 * 33]);
        *(v4u*)(WT + (size_t)(n0 + n) * K + k0 + 8 * c) = o; }
    LDS_WAIT(); asm volatile("" ::: "memory");
}

__device__ __forceinline__ void ada_item(const float* c, const float* W, const float* bias, float* mod, int cb, LAS unsigned char* lds, int tid) {
    const int lane = tid & 63, wave = tid >> 6;
    LAS float* sc = (LAS float*)lds + wave * 4096;
    for (int i = lane; i < 4096; i += 64) { const int b = i >> 7, kk = i & 127; const float v = c[b * DM + wave * 128 + kk]; sc[i] = v / (1.0f + __expf(-v)); }
    LDS_WAIT(); asm volatile("" ::: "memory");
    float acc[32];
#pragma unroll
    for (int b = 0; b < 32; ++b) acc[b] = 0.f;
    const float* Wp = W + (size_t)(wave * 128) * 3072 + cb * 64 + lane;
    for (int kk = 0; kk < 128; kk += 4) {
        const float w0 = Wp[(size_t)(kk + 0) * 3072], w1 = Wp[(size_t)(kk + 1) * 3072], w2 = Wp[(size_t)(kk + 2) * 3072], w3 = Wp[(size_t)(kk + 3) * 3072];
#pragma unroll
        for (int b = 0; b < 32; ++b) { const f32x4 s4 = *(const LAS f32x4*)(sc + b * 128 + kk); acc[b] += s4[0] * w0 + s4[1] * w1 + s4[2] * w2 + s4[3] * w3; }
    }
    __syncthreads();
    LAS float* red = (LAS float*)lds;
#pragma unroll
    for (int b = 0; b < 32; ++b) red[(wave * 32 + b) * 64 + lane] = acc[b];
    __syncthreads();
    for (int o = tid; o < 2048; o += 512) { const int b = o >> 6, col = o & 63; float sacc = 0.f;
#pragma unroll
        for (int w = 0; w < 8; ++w) sacc += red[(w * 32 + b) * 64 + col];
        mod[(size_t)b * 3072 + cb * 64 + col] = sacc + bias[cb * 64 + col]; }
    __syncthreads();
}

template <bool BF> __device__ __forceinline__ f32x4 ld_row4(const void* src, size_t row, int lane, int j) {
    if (BF) { typedef unsigned u32x2_ __attribute__((ext_vector_type(2))); const u32x2_ w = *((const u32x2_*)((const bf16raw*)src + row * DM) + lane + 64 * j);
        return (f32x4){__uint_as_float(w.x << 16), __uint_as_float(w.x & 0xffff0000u), __uint_as_float(w.y << 16), __uint_as_float(w.y & 0xffff0000u)}; }
    return *((const f32x4*)((const float*)src + row * DM) + lane + 64 * j);
}
template <bool BF>
__device__ __forceinline__ void norm_rows(const void* src, const float* g, const float* mod, bf16raw* H, int grow0, int lrow0, int nrows, int lane) {
    const int b = grow0 >> 11;
    f32x4 mul[4], add[4];
#pragma unroll
    for (int j = 0; j < 4; ++j) { const f32x4 gg = *(const f32x4*)(g + 4 * lane + 256 * j), sc = *(const f32x4*)(mod + (size_t)b * 3072 + 1024 + 4 * lane + 256 * j);
        mul[j] = gg * (sc + 1.0f); add[j] = *(const f32x4*)(mod + (size_t)b * 3072 + 4 * lane + 256 * j); }
    for (int r = 0; r < nrows; r += 4) {
        f32x4 v[4][4]; float s[4];
#pragma unroll
        for (int q = 0; q < 4; ++q) {
#pragma unroll
            for (int j = 0; j < 4; ++j) v[q][j] = ld_row4<BF>(src, (size_t)(grow0 + r + q), lane, j); }
#pragma unroll
        for (int q = 0; q < 4; ++q) { s[q] = 0.f;
#pragma unroll
            for (int j = 0; j < 4; ++j) s[q] += (v[q][j].x * v[q][j].x + v[q][j].y * v[q][j].y) + (v[q][j].z * v[q][j].z + v[q][j].w * v[q][j].w); }
#pragma unroll
        for (int o = 1; o < 64; o <<= 1) {
#pragma unroll
            for (int q = 0; q < 4; ++q) s[q] += __shfl_xor(s[q], o); }
#pragma unroll
        for (int q = 0; q < 4; ++q) { const float rstd = 1.0f / sqrtf(s[q] * (1.0f / DM) + NORM_EPS);
            unsigned long long* o8 = (unsigned long long*)(H + (size_t)(lrow0 + r + q) * DM) + lane;
#pragma unroll
            for (int j = 0; j < 4; ++j) { const f32x4 y = v[q][j] * rstd * mul[j] + add[j];
                o8[64 * j] = (unsigned long long)pk2(y.x, y.y) | ((unsigned long long)pk2(y.z, y.w) << 32); } }
    }
}
__device__ __forceinline__ void final_norm_rows(const bf16raw* x2, float* out, const float* g, int row0, int nrows, int lane) {
    f32x4 mul[4];
#pragma unroll
    for (int j = 0; j < 4; ++j) mul[j] = *(const f32x4*)(g + 4 * lane + 256 * j);
    for (int r = 0; r < nrows; r += 4) {
        f32x4 v[4][4]; float s[4];
#pragma unroll
        for (int q = 0; q < 4; ++q) {
#pragma unroll
            for (int j = 0; j < 4; ++j) v[q][j] = ld_row4<true>(x2, (size_t)(row0 + r + q), lane, j); }
#pragma unroll
        for (int q = 0; q < 4; ++q) { s[q] = 0.f;
#pragma unroll
            for (int j = 0; j < 4; ++j) s[q] += (v[q][j].x * v[q][j].x + v[q][j].y * v[q][j].y) + (v[q][j].z * v[q][j].z + v[q][j].w * v[q][j].w); }
#pragma unroll
        for (int o = 1; o < 64; o <<= 1) {
#pragma unroll
            for (int q = 0; q < 4; ++q) s[q] += __shfl_xor(s[q], o); }
#pragma unroll
        for (int q = 0; q < 4; ++q) { const float rstd = 1.0f / sqrtf(s[q] * (1.0f / DM) + NORM_EPS);
            f32x4* xw = (f32x4*)(out + (size_t)(row0 + r + q) * DM) + lane;
#pragma unroll
            for (int j = 0; j < 4; ++j) xw[64 * j] = v[q][j] * rstd * mul[j]; }
    }
}

__device__ __forceinline__ void fox_prep(const float* lf, const unsigned* kmx, int tok0, int h, LAS unsigned char* lds, int tid) {
    LAS float* cum = (LAS float*)(lds + att::L_CUM); LAS float* tot = (LAS float*)(lds + att::L_WSF); LAS unsigned* misc = (LAS unsigned*)(lds + att::L_MISC);
    __syncthreads();
    const int lane = tid & 63, wave = tid >> 6;
    const f32x4 lv = *(const f32x4*)(lf + ((size_t)((tok0 >> 11) * 32 + h)) * 2048 + 4 * tid);
    float a0 = lv[0], a1 = lv[1], a2 = lv[2], a3 = lv[3];
    a1 += a0; a2 += a1; a3 += a2;
    float inc = a3;
#pragma unroll
    for (int o = 1; o < 64; o <<= 1) { const float t = __int_as_float(__builtin_amdgcn_ds_bpermute((lane >= o ? lane - o : lane) << 2, __float_as_int(inc))); if (lane >= o) inc += t; }
    if (lane == 63) tot[wave] = inc;
    __syncthreads();
    float base = inc - a3;
    for (int w = 0; w < wave; ++w) base += tot[w];
    *(LAS f32x4*)(cum + 4 * tid) = (f32x4){a0 + base, a1 + base, a2 + base, a3 + base};
    if (tid < 2) misc[1 + tid] = __float_as_uint(sqrtf(__uint_as_float(__hip_atomic_load(kmx + tid, __ATOMIC_RELAXED, __HIP_MEMORY_SCOPE_AGENT))));
    __syncthreads();
}

#define XB_TMO      128
#define XB_XCNT(j)  (256  + 64 * (j))
#define XB_XSUB(j)  (1280 + 64 * (j))
#define XB_XGEN(j)  (2304 + 64 * (j))
#define XB_TOP      3328
#define XB_TOPGEN   3392
#define XCD_BAR_WORDS 3456
#define XB_SPIN_CAP (1u << 18)

__device__ __forceinline__ unsigned xb_ld(unsigned* p)              { return __hip_atomic_load(p, __ATOMIC_RELAXED, __HIP_MEMORY_SCOPE_AGENT); }
__device__ __forceinline__ unsigned xb_add(unsigned* p, unsigned v) { return __hip_atomic_fetch_add(p, v, __ATOMIC_RELAXED, __HIP_MEMORY_SCOPE_AGENT); }
__device__ __forceinline__ unsigned xb_xcc_id() { return (unsigned)__builtin_amdgcn_s_getreg((3 << 11) | 20) & 0xFu; }
#define XB_SPIN(cond, bar) do { unsigned _sp = 0; while (cond) { __builtin_amdgcn_s_sleep(1); \
    if ((++_sp & 255u) == 0u) { if (xb_ld(&(bar)[XB_TMO])) break; if (_sp > XB_SPIN_CAP) { atomicAdd(&(bar)[XB_TMO], 1u); break; } } } } while (0)

struct XcdBarrier {
    unsigned* bar; unsigned x;
    volatile LAS unsigned* st;
};

__device__ __forceinline__ XcdBarrier xcd_barrier_post(unsigned* bar, volatile LAS unsigned* st) {
    XcdBarrier b; b.bar = bar; b.x = xb_xcc_id(); b.st = st;
    if (threadIdx.x == 0) (void)xb_add(&bar[XB_XCNT(b.x)], 1u);
    return b;
}
__device__ __forceinline__ void xcd_barrier_complete(unsigned* bar, unsigned x, unsigned& nloc, unsigned& nx) {
    const unsigned G = gridDim.x * gridDim.y * gridDim.z;
    unsigned sum, cnt, mine, sp = 0u;
    for (;;) {
        sum = 0u; cnt = 0u; mine = 0u;
#pragma unroll
        for (unsigned j = 0; j < 16; ++j) { const unsigned c = xb_ld(&bar[XB_XCNT(j)]); sum += c; cnt += (c > 0u) ? 1u : 0u; mine = (j == x) ? c : mine; }
        if (sum == G) break;
        __builtin_amdgcn_s_sleep(1);
        if ((++sp & 255u) == 0u) { if (xb_ld(&bar[XB_TMO])) break; if (sp > XB_SPIN_CAP) { atomicAdd(&bar[XB_TMO], 1u); break; } }
    }
    nloc = mine > 0u ? mine : 1u; nx = cnt > 0u ? cnt : 1u;
}

__device__ __forceinline__ void xcd_barrier(const XcdBarrier& b) {
    asm volatile("s_waitcnt vmcnt(0)" ::: "memory");
    __syncthreads();
    if (threadIdx.x == 0) {
        unsigned* bar = b.bar;
        __builtin_amdgcn_s_waitcnt(0);
        unsigned nloc = b.st[0], nx = b.st[1];
        if (nloc == 0u) { xcd_barrier_complete(bar, b.x, nloc, nx); b.st[0] = nloc; b.st[1] = nx; }
        const unsigned old = xb_add(&bar[XB_XSUB(b.x)], 1u);
        const unsigned gen = old / nloc;
        if (old + 1u == (gen + 1u) * nloc) {
            __builtin_amdgcn_fence(__ATOMIC_RELEASE, "agent");
            asm volatile("s_waitcnt vmcnt(0)" ::: "memory");
            const unsigned og = xb_add(&bar[XB_TOP], 1u);
            const unsigned tg = og / nx;
            if (og + 1u == (tg + 1u) * nx) xb_add(&bar[XB_TOPGEN], 1u);
            else XB_SPIN(xb_ld(&bar[XB_TOPGEN]) == tg, bar);
            __builtin_amdgcn_fence(__ATOMIC_ACQUIRE, "agent");
            xb_add(&bar[XB_XGEN(b.x)], 1u);
            asm volatile("s_waitcnt vmcnt(0)" ::: "memory");
        } else {
            XB_SPIN(xb_ld(&bar[XB_XGEN(b.x)]) == gen, bar);
            __builtin_amdgcn_fence(__ATOMIC_ACQUIRE, "agent");
            asm volatile("s_waitcnt vmcnt(0)" ::: "memory");
        }
    }
    __syncthreads();
}

__device__ __forceinline__ void forget_task(const bf16raw* H, const bf16raw* Wf, const float* bfb, float* lf, int row0, int lane) {
    typedef short bf16x8_ __attribute__((ext_vector_type(8))); typedef float f32x16_ __attribute__((ext_vector_type(16)));
    const int r = lane & 31, hi = lane >> 5;
    const bf16x8_* ap = (const bf16x8_*)(H + (size_t)(row0 + r) * DM + hi * 8);
    const bf16x8_* bp = (const bf16x8_*)(Wf + (size_t)r * DM + hi * 8);
    f32x16_ acc = {};
#pragma unroll 8
    for (int ks = 0; ks < DM / 16; ++ks) acc = __builtin_amdgcn_mfma_f32_32x32x16_bf16(bp[2 * ks], ap[2 * ks], acc, 0, 0, 0);
    const int tok = row0 + r; float* lp = lf + ((size_t)(tok >> 11) * 32) * 2048 + (tok & 2047);
#pragma unroll
    for (int g = 0; g < 4; ++g) { const f32x4 bias = *(const f32x4*)(bfb + 8 * g + 4 * hi);
#pragma unroll
        for (int i = 0; i < 4; ++i) { const float xx = acc[4 * g + i] + bias[i];
            lp[(size_t)(8 * g + 4 * hi + i) * 2048] = (fminf(xx, 0.f) - log1pf(__expf(-fabsf(xx)))) * 1.4426950408889634f; } }
}

__device__ __forceinline__ int fresh_tid_(int wave_s) { int t = (wave_s << 6) | (int)__builtin_amdgcn_mbcnt_hi(~0u, __builtin_amdgcn_mbcnt_lo(~0u, 0u)); asm volatile("" : "+v"(t)); return t; }
#define fresh_tid() fresh_tid_(wave_s)
#define CAS __attribute__((address_space(4)))
__device__ __forceinline__ const CAS Params* launder(const CAS Params* q) { asm volatile("" : "+s"(q)); return q; }
#define PP (launder(kp0))
#ifndef PROBE_MASK
#define PROBE_MASK 0u
#endif
#if PROBE_MASK
#define STAMP(k) do { const unsigned long long t_ = __builtin_amdgcn_s_memrealtime(); if ((PROBE_MASK >> (k)) & 1u) pr_acc += t_ - pr_prev; pr_prev = t_; } while (0)
#else
#define STAMP(k) do { } while (0)
#endif
__global__ void __launch_bounds__(NWAVES * 64) mega_fwd(Params p_kernarg) {
    const CAS Params* const kp0 = (const CAS Params*)__builtin_amdgcn_kernarg_segment_ptr();
    extern __shared__ __attribute__((aligned(16))) unsigned char lds_raw[];
    cg::grid_group grid = cg::this_grid();
#if PROBE_MASK
    unsigned long long pr_prev = __builtin_amdgcn_s_memrealtime(), pr_acc = 0ull;
#endif
    LAS unsigned char* lds = (LAS unsigned char*)lds_raw;
    const int wave_s = __builtin_amdgcn_readfirstlane(threadIdx.x >> 6);
    if (threadIdx.x < 2) ((volatile LAS unsigned*)(lds + LDS_BARST))[threadIdx.x] = 0u;
    __syncthreads();
    XcdBarrier bar = xcd_barrier_post((unsigned*)(PP->ws + WS_BAR), (volatile LAS unsigned*)(lds + LDS_BARST));
    const int G = gridDim.x, bx = blockIdx.x; const int vcu = (G % 8 == 0) ? (bx % 8) * (G / 8) + bx / 8 : bx;
#define WIN_T(l) ((bf16raw*)(PP->ws + ((l) ? WS_WIN1 : WS_WIN0)))
#define WOUT_T(l) ((bf16raw*)(PP->ws + ((l) ? WS_WOUT1 : WS_WOUT0)))
#define MOD_ ((float*)(PP->ws + WS_MOD))
#define LF_ ((float*)(PP->ws + WS_LOGF))
#define H_ ((bf16raw*)(PP->ws + WS_H))
#define QB_ ((bf16raw*)(PP->ws + WS_Q))

    {
        const int tid = fresh_tid(), lane = tid & 63, wave = __builtin_amdgcn_readfirstlane(tid >> 6);
        LAS float* scr = (LAS float*)(lds + wave * 16384);
        const int NADA = (G >= 96) ? 96 : 0;
        const int NGW = (G - NADA) * NWAVES;
        const int gw = (bx < NADA) ? NGW : (bx - NADA) * NWAVES + wave;
        constexpr int I_IN0 = 16 * (NIN0_REAL / 32), I_IN1 = 16 * (NIN1 / 32), I_OUT = 32 * 32;
        constexpr int NITEMS = I_IN0 + I_OUT;
        for (int it = (gw < NGW ? gw : NITEMS); it < NITEMS; it += NGW) {
            int r = it;
            if (r < I_IN0) { transpose_item(PP->fwin, DM, NIN0_REAL, WIN_T(0), scr, r, lane); continue; } r -= I_IN0;
            transpose_item(PP->fwout, DI, DM, WOUT_T(0), scr, r, lane);
        }
        { v4u* z = (v4u*)(WIN_T(0) + (size_t)NIN0_REAL * DM); const int n16 = (NIN0 - NIN0_REAL) * DM * 2 / 16;
          for (int i = bx * 512 + tid; i < n16; i += G * 512) z[i] = (v4u){0u, 0u, 0u, 0u}; }
        if (bx == 0 && tid < 6) ((unsigned*)(PP->ws + WS_CNT))[16 * tid] = 0u;
        if (bx == 0) {
                       unsigned* kw = (unsigned*)(PP->ws + WS_KMX); for (int i = tid; i < NCHUNK * CHB * NH * 2; i += 512) kw[i] = 0u; }
        __syncthreads();
        for (int it = bx; it < 96; it += G) { const int l = it / 48, cb = it % 48;
            ada_item(PP->c, l ? PP->swada : PP->fwada, l ? PP->sbada : PP->fbada, MOD_ + (size_t)l * NB * 3072, cb, lds, tid); }
    }
    if (PP->ws == nullptr) grid.sync();
    xcd_barrier(bar); STAMP(0);
    const int rows_per_wave = CH / (G * NWAVES);
#define NORM_PHASE(l, ch) do { const int tid = fresh_tid(), lane = tid & 63, wave = __builtin_amdgcn_readfirstlane(tid >> 6); const int lr0 = (vcu * NWAVES + wave) * rows_per_wave; \
        if (l) norm_rows<true>((const void*)(PP->ws + WS_X1B), PP->sng, MOD_ + (size_t)NB * 3072, H_, (ch) * CH + lr0, lr0, rows_per_wave, lane); \
        else norm_rows<false>((const void*)PP->x, PP->fng, MOD_, H_, (ch) * CH + lr0, lr0, rows_per_wave, lane); } while (0)
    NORM_PHASE(0, 0);
    xcd_barrier(bar); STAMP(1);
    auto layer_chunk = [&](auto LC, auto CC) __attribute__((always_inline)) {
        constexpr int l = decltype(LC)::value, ch = decltype(CC)::value;
            {
                if (l == 0) { const int tid = fresh_tid(), lane = tid & 63, wave = __builtin_amdgcn_readfirstlane(tid >> 6);
                    for (int task = vcu * NWAVES + wave; task < CH / 32; task += G * NWAVES) forget_task(H_, WIN_T(0) + (size_t)NIN1 * DM, PP->fbf, LF_, task * 32, lane); }
                pg8::Gemm g{H_, WIN_T(l), CH, NIN1, DM}; pg8::StaticOrder S; S.init(CH, NIN1, G, bx);
                pg8::EpiProj E{QB_, QKVZ_STRIDE, att::C2, LF_, PP->fbf, l ? (unsigned*)nullptr : (unsigned*)(PP->ws + WS_KMX) + ch * CHB * NH * 2};
                pg8::gemm_phase<pg8::EpiProj, pg8::StaticOrder, true, true>(lds, g, S, E, fresh_tid());
            }
            xcd_barrier(bar); STAMP(2 + 3 * (l * NCHUNK + ch));
            {
                const att::bf16* Qp = (const att::bf16*)QB_; const att::bf16* Kp = Qp + QKVZ_STRIDE; const att::bf16* Vp = Kp + QKVZ_STRIDE; const att::bf16* Zp = Vp + QKVZ_STRIDE;
                LAS unsigned* misc = (LAS unsigned*)(lds + att::L_MISC); const int tid = fresh_tid();
                if (tid < 32) { unsigned rank = tid;
                    if (l == 0) { const float* bfp = PP->fbf; const float mine = bfp[tid]; rank = 0; for (int j = 0; j < 32; ++j) { const float o = bfp[j]; rank += (o > mine || (o == mine && j < tid)) ? 1u : 0u; } }
                    misc[32 + rank] = tid; }
                __syncthreads();
                unsigned* counter = (unsigned*)(PP->ws + WS_CNT) + 16 * (l * NCHUNK + ch);
                for (;;) {
                    if (tid == 0) misc[0] = atomicAdd(counter, 1u);
                    __syncthreads();
                    const int it = __builtin_amdgcn_readfirstlane(misc[0]);
                    if (it >= CHB * NH * 2) break;
                    const int it2 = it >> 1, qhi = (it & 1) ? 3 : att::NQB - 1, qlo = (it & 1) ? 0 : 4;
                    const int h = __builtin_amdgcn_readfirstlane(misc[32 + it2 / CHB]), tok0 = (it2 % CHB) * SEQ, rowbase = ((it2 % CHB) * NH + h) * SEQ;
                    if (l == 0) { fox_prep(LF_, (const unsigned*)(PP->ws + WS_KMX) + ((ch * CHB + it2 % CHB) * NH + h) * 2, tok0, h, lds, fresh_tid());
                        att::bh_item<0>(rowbase, qhi, qlo, Qp, Kp, Vp, Zp, (att::bf16*)QB_, (LAS char*)lds, fresh_tid()); }
                    else att::bh_item<1>(rowbase, qhi, qlo, Qp, Kp, Vp, Zp, (att::bf16*)QB_, (LAS char*)lds, fresh_tid());
                }
                asm volatile("s_waitcnt vmcnt(0) lgkmcnt(0)" ::: "memory"); __syncthreads();
                if (l == 0) {
                    constexpr int I_IN1 = 16 * (NIN1 / 32), I_OUT1 = 32 * 32, NB1 = (I_IN1 + I_OUT1) / 8, NBP = NB1 / NCHUNK;
                    unsigned* tq = (unsigned*)(PP->ws + WS_CNT) + 16 * (4 + ch);
                    const int t2 = fresh_tid(), lane2 = t2 & 63, wave2 = __builtin_amdgcn_readfirstlane(t2 >> 6);
                    LAS float* scr2 = (LAS float*)(lds + wave2 * 16384);
                    for (;;) {
                        if (t2 == 0) misc[0] = atomicAdd(tq, 1u);
                        __syncthreads();
                        const int bq = __builtin_amdgcn_readfirstlane(misc[0]);
                        __syncthreads();
                        if (bq >= NBP) break;
                        const int r = (ch * NBP + bq) * 8 + wave2;
                        if (r < I_IN1) transpose_item(PP->swin, DM, NIN1, WIN_T(1), scr2, r, lane2);
                        else transpose_item(PP->swout, DI, DM, WOUT_T(1), scr2, r - I_IN1, lane2);
                    }
                }
            }
            xcd_barrier(bar); STAMP(3 + 3 * (l * NCHUNK + ch));
            {
                pg8::Gemm g{QB_, WOUT_T(l), CH, DM, DI}; pg8::StaticOrder S; S.init(CH, DM, G, bx);
                pg8::EpiRes<(l != 0)> E{l ? (const void*)(PP->ws + WS_X1B) : (const void*)PP->x, (pg8::bf16_t*)(PP->ws + (l ? WS_X2B : WS_X1B)), MOD_ + (size_t)l * NB * 3072 + 2048, ch * CH};
                pg8::gemm_phase<pg8::EpiRes<(l != 0)>, pg8::StaticOrder, true, true, true>(lds, g, S, E, fresh_tid());
            }
            if (ch + 1 < NCHUNK) NORM_PHASE(l, ch + 1);
            else if (l == 0) NORM_PHASE(1, 0);
            xcd_barrier(bar); STAMP(4 + 3 * (l * NCHUNK + ch));
    };
    layer_chunk(std::integral_constant<int, 0>{}, std::integral_constant<int, 0>{});
    layer_chunk(std::integral_constant<int, 0>{}, std::integral_constant<int, 1>{});
    layer_chunk(std::integral_constant<int, 1>{}, std::integral_constant<int, 0>{});
    layer_chunk(std::integral_constant<int, 1>{}, std::integral_constant<int, 1>{});
    { const int tid = fresh_tid(), lane = tid & 63, wave = __builtin_amdgcn_readfirstlane(tid >> 6); const int rpw = MTOK / (G * NWAVES); final_norm_rows((const bf16raw*)(PP->ws + WS_X2B), PP->out, PP->fing, (vcu * NWAVES + wave) * rpw, rpw, lane); }
#if PROBE_MASK
    STAMP(14);
    if (bx == 0 && fresh_tid() == 0) { const unsigned long long t0_ = __builtin_amdgcn_s_memrealtime(); while (__builtin_amdgcn_s_memrealtime() - t0_ < pr_acc) __builtin_amdgcn_s_sleep(16); }
#endif
}

extern "C" void kernel_launch(void* const* d_in, const int* in_sizes, int n_in, void* d_out, int out_size, void* d_ws, size_t ws_size, hipStream_t stream) {
    static int grid = 0;
    if (grid == 0) {
        if (n_in != 14 || in_sizes[0] != MTOK * DM || out_size != MTOK * DM || ws_size < WS_END) { fprintf(stderr, "kernel_launch: unexpected shapes (n_in %d, in0 %d, out %d, ws %zu < %zu); nothing launched\n", n_in, n_in > 0 ? in_sizes[0] : -1, out_size, ws_size, (size_t)WS_END); grid = -1; return; }
        int dev = 0, cus = 0, per_cu = 0;
        if (hipGetDevice(&dev) != hipSuccess || hipDeviceGetAttribute(&cus, hipDeviceAttributeMultiprocessorCount, dev) != hipSuccess) { grid = -1; return; }
        if (hipFuncSetAttribute((const void*)mega_fwd, hipFuncAttributeMaxDynamicSharedMemorySize, LDS_BYTES) != hipSuccess) { fprintf(stderr, "kernel_launch: hipFuncSetAttribute failed\n"); grid = -1; return; }
        if (hipOccupancyMaxActiveBlocksPerMultiprocessor(&per_cu, (const void*)mega_fwd, NWAVES * 64, LDS_BYTES) != hipSuccess || per_cu < 1) { fprintf(stderr, "kernel_launch: occupancy query gave %d\n", per_cu); per_cu = 1; }
        (void)hipGetLastError();
        grid = cus * per_cu;
        if (CH % (grid * NWAVES) != 0 || grid % 8 != 0) { fprintf(stderr, "kernel_launch: grid %d does not divide the row split\n", grid); grid = -1; return; }
    }
    if (grid < 0) return;
    Params p{};
    p.x = (const float*)d_in[0]; p.c = (const float*)d_in[1]; p.fng = (const float*)d_in[2]; p.fwada = (const float*)d_in[3]; p.fbada = (const float*)d_in[4];
    p.fwin = (const float*)d_in[5]; p.fbf = (const float*)d_in[6]; p.fwout = (const float*)d_in[7]; p.sng = (const float*)d_in[8]; p.swada = (const float*)d_in[9];
    p.sbada = (const float*)d_in[10]; p.swin = (const float*)d_in[11]; p.swout = (const float*)d_in[12]; p.fing = (const float*)d_in[13];
    p.out = (float*)d_out; p.ws = (unsigned char*)d_ws;
    if (hipMemsetAsync((unsigned char*)d_ws + WS_BAR, 0, XCD_BAR_WORDS * 4, stream) != hipSuccess) { fprintf(stderr, "kernel_launch: hipMemsetAsync failed\n"); return; }
    void* args[] = {&p};
    hipError_t e = hipLaunchCooperativeKernel((const void*)mega_fwd, dim3(grid), dim3(NWAVES * 64), args, LDS_BYTES, stream);
    if (e != hipSuccess) fprintf(stderr, "kernel_launch: cooperative launch failed: %s (grid %d)\n", hipGetErrorString(e), grid);
}
```
